# Optimizing an MI355X kernel written in HIP

```python
import math
import jax, jax.numpy as jnp
from jax import lax
import numpy as np

D_MODEL = 1024
BATCH = 16
SEQ = 2048
DEPTH = 4

N_MEM = 256
HEAD_DIM = 64
N_MEM_HEADS = 4
MEM_W = N_MEM_HEADS * HEAD_DIM
MAIN_W = D_MODEL - MEM_W
MIX_W = MAIN_W + MEM_W
POOL_WINDOWS = (2, 4, 8, 16)
POOL_GROUP = MAIN_W // len(POOL_WINDOWS)
DIL_PATTERNS = ((128, 1), (512, 4), (2048, 16))
N_GROUPS = len(DIL_PATTERNS)
HEADS_PER_GROUP = MAIN_W // (N_GROUPS * HEAD_DIM)
N_DIL_HEADS = N_GROUPS * HEADS_PER_GROUP
N_A_LAYERS = DEPTH // 2
N_B_LAYERS = DEPTH - N_A_LAYERS
D_FF = ((8 * D_MODEL + 3 * 256 - 1) // (3 * 256)) * 256
ROPE_THETA = 10000.0
EPS = 1e-6
NEG = -1e30

kernel_name = "yoco_pool_dilated_hybrid"


def rms_norm(x, g):
    xf = x.astype(jnp.float32)
    y = xf * lax.rsqrt(jnp.mean(xf * xf, axis=-1, keepdims=True) + EPS)
    return (y * g.astype(jnp.float32)).astype(x.dtype)


def rope(t, positions):
    half = HEAD_DIM // 2
    freqs = ROPE_THETA ** (-jnp.arange(half, dtype=jnp.float32) / half)
    ang = positions.astype(jnp.float32)[..., None] * freqs
    cos = jnp.cos(ang)[:, :, None, :]
    sin = jnp.sin(ang)[:, :, None, :]
    tf = t.astype(jnp.float32)
    t1, t2 = tf[..., :half], tf[..., half:]
    return jnp.concatenate([t1 * cos - t2 * sin, t1 * sin + t2 * cos], axis=-1).astype(t.dtype)


def pool_mixer(u, w_pool, scale):
    S = u.shape[1]
    uf = u.astype(jnp.float32)
    c = jnp.cumsum(uf, axis=1)
    t = jnp.arange(S)
    outs = []
    for gi, w in enumerate(POOL_WINDOWS):
        sl = slice(gi * POOL_GROUP, (gi + 1) * POOL_GROUP)
        cg = c[..., sl]
        shifted = jnp.pad(cg, ((0, 0), (w, 0), (0, 0)))[:, :S]
        cnt = jnp.minimum(t + 1, w).astype(jnp.float32)[None, :, None]
        outs.append((cg - shifted) / cnt - uf[..., sl])
    p = jnp.stack(outs, axis=2).astype(u.dtype)
    y = jnp.einsum('bsgc,gce->bsge', p, w_pool).reshape(u.shape)
    return y * scale


def to_strided(t, d):
    B, S = t.shape[:2]
    return t.reshape((B, S // d, d) + t.shape[2:]).swapaxes(1, 2)


def kv_blocks(t, d, steps):
    s = to_strided(t, d)
    B, _, L, H, hd = s.shape
    nb = -(-L // steps)
    Lp = nb * steps
    s = jnp.pad(s, ((0, 0), (0, 0), (steps, Lp - L), (0, 0), (0, 0)))
    s = s.reshape(B, d, nb + 1, steps, H, hd)
    return jnp.concatenate([s[:, :, :-1], s[:, :, 1:]], axis=3)


def band_mask(nb, steps):
    i = jnp.arange(steps)[:, None] + steps
    j = jnp.arange(2 * steps)[None, :]
    rel = i - j
    m = (rel >= 0) & (rel <= steps)
    n = jnp.arange(nb)[:, None, None]
    return m[None] & ((n > 0) | (j >= steps)[None])


def dilated_group_attn(q, kk, vv, d, steps):
    B, S, H, hd = q.shape
    L = S // d
    nb = kk.shape[2]
    Lp = nb * steps
    qs = jnp.pad(to_strided(q, d), ((0, 0), (0, 0), (0, Lp - L), (0, 0), (0, 0)))
    qs = qs.reshape(B, d, nb, steps, H, hd)
    s = jnp.einsum('bdnqhe,bdnkhe->bdnhqk', qs, kk).astype(jnp.float32) * (HEAD_DIM ** -0.5)
    s = jnp.where(band_mask(nb, steps)[None, None, :, None], s, NEG)
    lse = jax.nn.logsumexp(s, axis=-1)
    p = jnp.exp(s - lse[..., None]).astype(vv.dtype)
    o = jnp.einsum('bdnhqk,bdnkhe->bdnqhe', p, vv)
    o = o.reshape(B, d, Lp, H, hd)[:, :, :L].swapaxes(1, 2).reshape(B, S, H, hd)
    lse = lse.transpose(0, 1, 2, 4, 3).reshape(B, d, Lp, H)[:, :, :L].swapaxes(1, 2).reshape(B, S, H)
    return o, lse


def build_shared_kv(x, positions, kv_norm, w_kv):
    B, S, _ = x.shape
    kv = rms_norm(x, kv_norm) @ w_kv
    k = rope(kv[..., :MAIN_W].reshape(B, S, N_DIL_HEADS, HEAD_DIM), positions)
    v = kv[..., MAIN_W:].reshape(B, S, N_DIL_HEADS, HEAD_DIM)
    k = k.reshape(B, S, N_GROUPS, HEADS_PER_GROUP, HEAD_DIM)
    v = v.reshape(B, S, N_GROUPS, HEADS_PER_GROUP, HEAD_DIM)
    shared = []
    for g, (win, d) in enumerate(DIL_PATTERNS):
        steps = win // d
        shared.append((kv_blocks(k[:, :, g], d, steps), kv_blocks(v[:, :, g], d, steps)))
    return shared


def dilated_mixer(zq, positions, shared):
    B, S, _ = zq.shape
    q = rope(zq.reshape(B, S, N_DIL_HEADS, HEAD_DIM), positions)
    q = q.reshape(B, S, N_GROUPS, HEADS_PER_GROUP, HEAD_DIM)
    outs, lses = [], []
    for g, (win, d) in enumerate(DIL_PATTERNS):
        kk, vv = shared[g]
        o, l = dilated_group_attn(q[:, :, g], kk, vv, d, win // d)
        outs.append(o)
        lses.append(l)
    o = jnp.stack(outs, axis=2)
    alpha = jax.nn.softmax(jnp.stack(lses, axis=2), axis=2)
    return (o * alpha[..., None].astype(o.dtype)).reshape(B, S, MAIN_W)


def memory_attn(zm, mem, g, w_mkv):
    B, S, _ = zm.shape
    M = mem.shape[1]
    q = zm.reshape(B, S, N_MEM_HEADS, HEAD_DIM)
    kv = rms_norm(mem, g) @ w_mkv
    km = kv[..., :MEM_W].reshape(B, M, N_MEM_HEADS, HEAD_DIM)
    vm = kv[..., MEM_W:].reshape(B, M, N_MEM_HEADS, HEAD_DIM)
    s = jnp.einsum('bshe,bmhe->bhsm', q, km).astype(jnp.float32) * (HEAD_DIM ** -0.5)
    p = jax.nn.softmax(s, axis=-1).astype(vm.dtype)
    return jnp.einsum('bhsm,bmhe->bshe', p, vm).reshape(B, S, MEM_W)


def setup_inputs(seed: int = 0) -> dict:
    key = jax.random.key(seed)
    ks = jax.random.split(key, 14)
    f32 = jnp.float32
    nrm = lambda k, shape, fan: jax.random.normal(k, shape, f32) * (fan ** -0.5)
    return {
        "x": jax.random.normal(ks[0], (BATCH, SEQ, D_MODEL), f32),
        "mem": jax.random.normal(ks[1], (BATCH, N_MEM, D_MODEL), f32),
        "positions": jnp.broadcast_to(jnp.arange(SEQ, dtype=jnp.int32)[None], (BATCH, SEQ)),
        "norm_gains": 1.0 + 0.05 * jax.random.normal(ks[2], (DEPTH, 4, D_MODEL), f32),
        "mem_norm": 1.0 + 0.05 * jax.random.normal(ks[3], (DEPTH, D_MODEL), f32),
        "w_in": nrm(ks[4], (DEPTH, D_MODEL, MIX_W), D_MODEL),
        "w_mem_kv": nrm(ks[5], (DEPTH, D_MODEL, 2 * MEM_W), D_MODEL),
        "w_out": nrm(ks[6], (DEPTH, MIX_W, D_MODEL), MIX_W),
        "w_pool": nrm(ks[7], (N_A_LAYERS, len(POOL_WINDOWS), POOL_GROUP, POOL_GROUP), POOL_GROUP),
        "pool_scale": 1.0 + 0.1 * jax.random.normal(ks[8], (N_A_LAYERS, MAIN_W), f32),
        "kv_norm": 1.0 + 0.05 * jax.random.normal(ks[9], (D_MODEL,), f32),
        "w_kv": nrm(ks[10], (D_MODEL, 2 * MAIN_W), D_MODEL),
        "w_gate_up": nrm(ks[11], (DEPTH, D_MODEL, 2 * D_FF), D_MODEL),
        "w_down": nrm(ks[12], (DEPTH, D_FF, D_MODEL), D_FF),
    }


def reference(x, mem, positions, norm_gains, mem_norm, w_in, w_mem_kv, w_out,
              w_pool, pool_scale, kv_norm, w_kv, w_gate_up, w_down):
    shared = None
    for l in range(DEPTH):
        h = rms_norm(x, norm_gains[l, 0])
        z = h @ w_in[l]
        z_main, z_mem = z[..., :MAIN_W], z[..., MAIN_W:]
        if l < N_A_LAYERS:
            y_main = pool_mixer(z_main, w_pool[l], pool_scale[l])
        else:
            y_main = dilated_mixer(z_main, positions, shared)
        y_mem = memory_attn(z_mem, mem, mem_norm[l], w_mem_kv[l])
        y = jnp.concatenate([y_main, y_mem], axis=-1) @ w_out[l]
        x = x + rms_norm(y, norm_gains[l, 1])
        h = rms_norm(x, norm_gains[l, 2])
        gu = h @ w_gate_up[l]
        y = (jax.nn.silu(gu[..., :D_FF]) * gu[..., D_FF:]) @ w_down[l]
        x = x + rms_norm(y, norm_gains[l, 3])
        if l == N_A_LAYERS - 1:
            shared = build_shared_kv(x, positions, kv_norm, w_kv)
    return x
```

```cpp
#include <hip/hip_runtime.h>
#include <hip/hip_cooperative_groups.h>
#include <cstdio>
#include <cstdint>
namespace cg = cooperative_groups;
namespace pg8 {
#define PG8_LAS __attribute__((address_space(3)))
typedef unsigned short bf16_t;
typedef short bf16x8 __attribute__((ext_vector_type(8)));
typedef float f32x4 __attribute__((ext_vector_type(4)));
typedef unsigned u32x4 __attribute__((ext_vector_type(4)));
constexpr int BM = 256, BK = 64, HALF = 128, HTB = HALF * BK * 2  , STAGE_BYTES = 8 * HTB, NXCD = 8, WGM = 8;

__host__ __device__ __forceinline__ int lds_byte(int r, int c) { const int st = (r >> 4) * 2 + (c >> 5), rr = r & 15, cc = c & 31, ob = rr * 64 + cc * 2; return st * 1024 + (ob ^ (((ob >> 9) & 1) << 5)); }
__host__ __device__ __forceinline__ void stage_rc(int b, int& R, int& C) { const int st = b / 1024, sb = b % 1024, swz = sb ^ (((sb >> 9) & 1) << 5); R = (st >> 1) * 16 + swz / 64; C = (st & 1) * 32 + (swz % 64) / 2; }
__host__ __device__ __forceinline__ int perm32(int rho) { const int n = rho >> 4, i = rho & 15; return 8 * (i >> 2) + 4 * n + (i & 3); }

struct Unit { int pm, pn; };
struct Gemm { const bf16_t* A; const bf16_t* Bt; int M, N, K; };

struct StaticOrder {
    int nM, nN, nwg, G, c;
    __host__ __device__ void init(int M, int N, int G_, int c_) { nM = M / BM; nN = N / BM; nwg = nM * nN; G = G_; c = c_; }
    __host__ __device__ bool next(int i, Unit& u) const {
        const long L = (long)i * G + c; if (L >= nwg) return false;
        int wgid = (int)L; { const int q = nwg / NXCD, r = nwg % NXCD, xcd = wgid % NXCD, off = wgid / NXCD; wgid = (xcd < r ? xcd * (q + 1) : r * (q + 1) + (xcd - r) * q) + off; }
        const int nig = WGM * nN, gid = wgid / nig, fm = gid * WGM, gsz = (nM - fm) < WGM ? (nM - fm) : WGM;
        u.pm = fm + ((wgid % nig) % gsz); u.pn = (wgid % nig) / gsz; return true;
    }
    __device__ __forceinline__ void a_ready(const Unit&) const {}
    __device__ __forceinline__ void done(const Unit&) const {}
};

__device__ __forceinline__ unsigned cvt_pk_bf16(float lo, float hi) { unsigned r; asm volatile("v_cvt_pk_bf16_f32 %0, %1, %2" : "=v"(r) : "v"(lo), "v"(hi)); return r; }
constexpr float C2 = 0.125f * 1.4426950408889634f;
struct EpiAll {
    static constexpr bool PERM = true, AFTER_DRAIN = false;
    int kind; bf16_t* o0; bf16_t* o1; const float* rs; const float* rope;
    __device__ __forceinline__ void operator()(const f32x4 (&acc)[2][2][4][2], const Unit& u, int wr, int wc, int fr, int fq) const {
        const int row0 = u.pm * BM + wr * 64 + fr;
        if (kind <= 2) {
            bf16_t* base; int ldc, colt; bool rp = false; float sc = 1.f;
            if (kind == 0) { base = o0; ldc = 1024; colt = u.pn * 256; if (u.pn == 3) sc = C2; }
            else if (kind == 1) { if (u.pn < 4) { base = o0; ldc = 1024; colt = u.pn * 256; rp = u.pn < 3; sc = C2; } else { base = o1; ldc = 1536; colt = u.pn * 256 - 1024; rp = u.pn < 7; } }
            else { base = o0 + (size_t)(u.pn >> 1) * 4096 * 512; ldc = 512; colt = (u.pn & 1) * 256; }
#pragma unroll
            for (int ai = 0; ai < 2; ++ai)
#pragma unroll
                for (int m = 0; m < 4; ++m) { const int r = row0 + ai * HALF + m * 16; const float rsv = rs[r] * sc;
#pragma unroll
                    for (int bj = 0; bj < 2; ++bj) { const int c = colt + bj * HALF + wc * 32 + fq * 8;
                        f32x4 v0 = acc[ai][bj][m][0] * rsv, v1 = acc[ai][bj][m][1] * rsv;
                        if (rp) { const int j = (c & 63) >> 3; const f32x4 cs = *(const f32x4*)(rope + (size_t)r * 64 + 4 * j), sn = *(const f32x4*)(rope + (size_t)r * 64 + 32 + 4 * j);
                            const f32x4 a = v0 * cs - v1 * sn, b = v0 * sn + v1 * cs; v0 = a; v1 = b; }
                        u32x4 w; w.x = cvt_pk_bf16(v0[0], v0[1]); w.y = cvt_pk_bf16(v0[2], v0[3]); w.z = cvt_pk_bf16(v1[0], v1[1]); w.w = cvt_pk_bf16(v1[2], v1[3]);
                        *(u32x4*)(base + (size_t)r * ldc + c) = w; } }
        } else if (kind == 3) {
#pragma unroll
            for (int ai = 0; ai < 2; ++ai)
#pragma unroll
                for (int m = 0; m < 4; ++m) { const int r = row0 + ai * HALF + m * 16;
#pragma unroll
                    for (int bj = 0; bj < 2; ++bj) { const int c = u.pn * 256 + bj * HALF + wc * 32 + fq * 8;
                        const f32x4 v0 = acc[ai][bj][m][0], v1 = acc[ai][bj][m][1];
                        u32x4 w; w.x = cvt_pk_bf16(v0[0], v0[1]); w.y = cvt_pk_bf16(v0[2], v0[3]); w.z = cvt_pk_bf16(v1[0], v1[1]); w.w = cvt_pk_bf16(v1[2], v1[3]);
                        *(u32x4*)(o0 + (size_t)r * 1024 + c) = w; } }
        } else {
            typedef unsigned u32x2 __attribute__((ext_vector_type(2)));
#pragma unroll
            for (int ai = 0; ai < 2; ++ai)
#pragma unroll
                for (int m = 0; m < 4; ++m) { const int r = row0 + ai * HALF + m * 16; const float rsv = rs[r];
#pragma unroll
                    for (int bj = 0; bj < 2; ++bj) { const int c = u.pn * 128 + bj * 64 + wc * 16 + fq * 4;
                        const f32x4 g = acc[ai][bj][m][0] * rsv, up = acc[ai][bj][m][1] * rsv; f32x4 h;
#pragma unroll
                        for (int t = 0; t < 4; ++t) h[t] = g[t] * __builtin_amdgcn_rcpf(1.f + __builtin_amdgcn_exp2f(-1.4426950408889634f * g[t])) * up[t];
                        u32x2 w; w.x = cvt_pk_bf16(h[0], h[1]); w.y = cvt_pk_bf16(h[2], h[3]);
                        *(u32x2*)(o0 + (size_t)r * 2816 + c) = w; } }
        }
    }
};

template <int KC, class Epi, class Sched, bool ALIGN_EPI = false, bool SP2 = false>
__device__ __forceinline__ void gemm_phase(PG8_LAS unsigned char* lds, const Gemm g, const Sched& S, const Epi& E) {
    int tid_ = threadIdx.x; asm volatile("" : "+v"(tid_));
    const int tid = tid_, wid = __builtin_amdgcn_readfirstlane(tid >> 6), lane = tid & 63, wr = wid >> 2, wc = wid & 3, fr = lane & 15, fq = lane >> 4;
    constexpr int K = KC, nt = K / BK;
    unsigned voffA[2], voffB[2];
#pragma unroll
    for (int i = 0; i < 2; ++i) { int R, C; stage_rc(tid * 16 + i * 8192, R, C); const int Rb = Epi::PERM ? ((R & ~31) + perm32(R & 31)) : R;
        voffA[i] = (unsigned)(R * K + C) * 2u; voffB[i] = (unsigned)(Rb * K + C) * 2u; }
    const size_t kstep = (size_t)(BK * 2);
    const size_t hstep = (size_t)HALF * K * 2;
    const size_t tstep = 2 * hstep;
    const unsigned ldsw = (unsigned)wid * 1024u;
    const int aoff = lds_byte(wr * 64 + fr, fq * 8), boff = lds_byte(wc * 32 + fr, fq * 8);
#define PG8_SA(b, h) (((b) * 2 + (h)) * HTB)
#define PG8_SB(b, h) ((4 + (b) * 2 + (h)) * HTB)
#define PG8_STAGE(bufoff, gbase, voff) do { _Pragma("unroll") for (int _i = 0; _i < 2; ++_i) \
        __builtin_amdgcn_global_load_lds((const unsigned*)((const char*)(gbase) + (voff)[_i]), (PG8_LAS unsigned*)(lds + (bufoff) + ldsw + _i * 8192), 16, 0, 0); } while (0)
#define PG8_LDA(dst, b, h) do { _Pragma("unroll") for (int m = 0; m < 4; ++m) _Pragma("unroll") for (int k = 0; k < 2; ++k) dst[m][k] = *(const PG8_LAS bf16x8*)(lds + PG8_SA(b, h) + aoff + m * 2048 + k * 1024); } while (0)
#define PG8_LDB(dst, b, h) do { _Pragma("unroll") for (int n = 0; n < 2; ++n) _Pragma("unroll") for (int k = 0; k < 2; ++k) dst[n][k] = *(const PG8_LAS bf16x8*)(lds + PG8_SB(b, h) + boff + n * 2048 + k * 1024); } while (0)
#define PG8_MMA(ai, bj, At, Bt) do { __builtin_amdgcn_s_setprio(1); _Pragma("unroll") for (int m = 0; m < 4; ++m) _Pragma("unroll") for (int n = 0; n < 2; ++n) _Pragma("unroll") for (int k = 0; k < 2; ++k) \
        acc[ai][bj][m][n] = __builtin_amdgcn_mfma_f32_16x16x32_bf16(Bt[n][k], At[m][k], acc[ai][bj][m][n], 0, 0, 0); __builtin_amdgcn_s_setprio(0); } while (0)
#define PG8_WAIT_V(n) asm volatile("s_waitcnt vmcnt(" #n ")" ::: "memory")
#define PG8_WAIT_L(n) asm volatile("s_waitcnt lgkmcnt(" #n ")" ::: "memory")
#define PG8_BAR __builtin_amdgcn_s_barrier()
#define PG8_SCHED __builtin_amdgcn_sched_barrier(0)
    Unit cur, nxt; int ui = 0;
    if (!S.next(0, cur)) return;
    f32x4 acc[2][2][4][2];
#pragma unroll
    for (int a = 0; a < 2; ++a)
#pragma unroll
        for (int b = 0; b < 2; ++b)
#pragma unroll
            for (int m = 0; m < 4; ++m)
#pragma unroll
                for (int n = 0; n < 2; ++n) acc[a][b][m][n] = (f32x4){0.f, 0.f, 0.f, 0.f};
    bf16x8 At[4][2], B0[2][2], B1[2][2];
    const char* cA = (const char*)g.A + (size_t)cur.pm * tstep; const char* cB = (const char*)g.Bt + (size_t)cur.pn * tstep;
    S.a_ready(cur);
    if constexpr (SP2) {
        PG8_STAGE(PG8_SB(0, 0), cB, voffB); PG8_STAGE(PG8_SB(0, 1), cB + hstep, voffB); PG8_STAGE(PG8_SA(0, 0), cA, voffA); PG8_STAGE(PG8_SA(0, 1), cA + hstep, voffA);
        if (wr == 1) PG8_BAR;
        PG8_WAIT_V(2); PG8_BAR;
        PG8_STAGE(PG8_SB(1, 0), cB + kstep, voffB); PG8_STAGE(PG8_SA(1, 0), cA + kstep, voffA); PG8_STAGE(PG8_SB(1, 1), cB + hstep + kstep, voffB);
        PG8_WAIT_V(6); PG8_BAR;
    } else {
        PG8_STAGE(PG8_SB(0, 0), cB, voffB); PG8_STAGE(PG8_SA(0, 0), cA, voffA); PG8_STAGE(PG8_SB(0, 1), cB + hstep, voffB); PG8_STAGE(PG8_SA(0, 1), cA + hstep, voffA);
        if (wr == 1) PG8_BAR;
        PG8_WAIT_V(4); PG8_BAR;
        PG8_STAGE(PG8_SB(1, 0), cB + kstep, voffB); PG8_STAGE(PG8_SA(1, 0), cA + kstep, voffA); PG8_STAGE(PG8_SB(1, 1), cB + hstep + kstep, voffB);
        PG8_WAIT_V(6); PG8_BAR;
    }
    for (;;) {
        const bool has_next = S.next(ui + 1, nxt);
        const char* nA = has_next ? (const char*)g.A + (size_t)nxt.pm * tstep : cA; const char* nB = has_next ? (const char*)g.Bt + (size_t)nxt.pn * tstep : cB;
        for (int t = 0; t < nt; t += 2) {
            const bool last = (t == nt - 2);
            const char* a1 = cA + (size_t)(t + 1) * kstep;
            const char* a2 = last ? nA : cA + (size_t)(t + 2) * kstep; const char* b2 = last ? nB : cB + (size_t)(t + 2) * kstep;
            const char* a3 = a2 + kstep; const char* b3 = b2 + kstep;
            if (last && has_next) S.a_ready(nxt);
            if constexpr (SP2) {
            PG8_LDB(B0, 0, 0); PG8_LDB(B1, 0, 1); PG8_SCHED; PG8_LDA(At, 0, 0); PG8_STAGE(PG8_SA(1, 1), a1 + hstep, voffA);
            PG8_WAIT_V(8); PG8_WAIT_L(0); PG8_BAR; PG8_MMA(0, 0, At, B0); PG8_MMA(0, 1, At, B1); PG8_BAR; PG8_SCHED;
            PG8_LDA(At, 0, 1); PG8_STAGE(PG8_SB(0, 0), b2, voffB); PG8_STAGE(PG8_SB(0, 1), b2 + hstep, voffB); PG8_STAGE(PG8_SA(0, 0), a2, voffA);
            PG8_WAIT_V(8); PG8_WAIT_L(0); PG8_BAR; PG8_MMA(1, 0, At, B0); PG8_MMA(1, 1, At, B1); PG8_BAR; PG8_SCHED;
            PG8_LDB(B0, 1, 0); PG8_LDB(B1, 1, 1); PG8_SCHED; PG8_LDA(At, 1, 0); PG8_STAGE(PG8_SA(0, 1), a2 + hstep, voffA);
            PG8_WAIT_V(8); PG8_WAIT_L(0); PG8_BAR; PG8_MMA(0, 0, At, B0); PG8_MMA(0, 1, At, B1); PG8_BAR; PG8_SCHED;
            PG8_LDA(At, 1, 1); PG8_STAGE(PG8_SB(1, 0), b3, voffB); PG8_STAGE(PG8_SB(1, 1), b3 + hstep, voffB); PG8_STAGE(PG8_SA(1, 0), a3, voffA);
            PG8_WAIT_V(8); PG8_WAIT_L(0); PG8_BAR; PG8_MMA(1, 0, At, B0); PG8_MMA(1, 1, At, B1); PG8_BAR; PG8_SCHED;
            } else {
            PG8_LDB(B0, 0, 0); PG8_SCHED; PG8_LDA(At, 0, 0); PG8_STAGE(PG8_SA(1, 1), a1 + hstep, voffA);
            PG8_WAIT_L(8); PG8_BAR; PG8_WAIT_L(0); PG8_MMA(0, 0, At, B0); PG8_BAR; PG8_SCHED;
            PG8_LDB(B1, 0, 1); PG8_STAGE(PG8_SB(0, 0), b2, voffB);
            PG8_BAR; PG8_WAIT_L(0); PG8_MMA(0, 1, At, B1); PG8_BAR;
            PG8_LDA(At, 0, 1); PG8_STAGE(PG8_SA(0, 0), a2, voffA);
            PG8_BAR; PG8_WAIT_L(0); PG8_MMA(1, 0, At, B0); PG8_BAR; PG8_SCHED;
            PG8_STAGE(PG8_SB(0, 1), b2 + hstep, voffB);
            PG8_WAIT_V(6); PG8_BAR; PG8_MMA(1, 1, At, B1); PG8_BAR;
            PG8_LDB(B0, 1, 0); PG8_SCHED; PG8_LDA(At, 1, 0); PG8_STAGE(PG8_SA(0, 1), a2 + hstep, voffA);
            PG8_WAIT_L(8); PG8_BAR; PG8_WAIT_L(0); PG8_MMA(0, 0, At, B0); PG8_BAR; PG8_SCHED;
            PG8_LDB(B1, 1, 1); PG8_STAGE(PG8_SB(1, 0), b3, voffB);
            PG8_BAR; PG8_WAIT_L(0); PG8_MMA(0, 1, At, B1); PG8_BAR;
            PG8_LDA(At, 1, 1); PG8_STAGE(PG8_SA(1, 0), a3, voffA);
            PG8_BAR; PG8_WAIT_L(0); PG8_MMA(1, 0, At, B0); PG8_BAR; PG8_SCHED;
            PG8_STAGE(PG8_SB(1, 1), b3 + hstep, voffB);
            PG8_WAIT_V(6); PG8_BAR; PG8_MMA(1, 1, At, B1); PG8_BAR;
            }
        }
        if constexpr (ALIGN_EPI) { if (wr == 0) PG8_BAR; }
        if constexpr (!Epi::AFTER_DRAIN) { E(acc, cur, wr, wc, fr, fq); S.done(cur); }
        if (!has_next) break;
#pragma unroll
        for (int a = 0; a < 2; ++a)
#pragma unroll
            for (int b = 0; b < 2; ++b)
#pragma unroll
                for (int m = 0; m < 4; ++m)
#pragma unroll
                    for (int n = 0; n < 2; ++n) acc[a][b][m][n] = (f32x4){0.f, 0.f, 0.f, 0.f};
        cur = nxt; cA = nA; cB = nB; ++ui;
        if constexpr (ALIGN_EPI) { if (wr == 1) PG8_BAR; }
    }
    PG8_WAIT_V(0);
    if constexpr (!ALIGN_EPI) { if (wr == 0) PG8_BAR; }
    PG8_BAR;
    if constexpr (Epi::AFTER_DRAIN) { E.fused(acc, cur, wr, wc, fr, fq, lds, wid, lane); S.done(cur); }
#undef PG8_SA
#undef PG8_SB
#undef PG8_STAGE
#undef PG8_LDA
#undef PG8_LDB
#undef PG8_MMA
#undef PG8_WAIT_V
#undef PG8_WAIT_L
#undef PG8_BAR
#undef PG8_SCHED
}
}
#define LAS __attribute__((address_space(3)))
typedef unsigned short bf16;
typedef float f32x4 __attribute__((ext_vector_type(4)));
typedef short bf16x8 __attribute__((ext_vector_type(8)));
typedef unsigned u32x4 __attribute__((ext_vector_type(4)));
typedef unsigned u32x2 __attribute__((ext_vector_type(2)));
typedef short v4i16_t __attribute__((ext_vector_type(4)));
constexpr int DM = 1024, NB = 16, SEQ = 2048, MT = NB * SEQ, NMEM = 256, MMEM = NB * NMEM, DFF = 2816, MAINW = 768;
constexpr float EPS = 1e-6f;
constexpr size_t MiB = 1u << 20;
constexpr size_t WS_SSQ = 0, WS_RX = 1 * MiB, WS_RMEM = 1 * MiB + 256 * 1024, WS_LSE = 2 * MiB, WS_ROPE = 4 * MiB, WS_MEMB = 12 * MiB, WS_KVM = 20 * MiB;
constexpr size_t WS_W = 36 * MiB, WL_STRIDE = 24 * MiB, WL_IN = 0, WL_OUT = 5 * MiB, WL_GU = 7 * MiB, WL_DOWN = 18 * MiB;
constexpr size_t WS_WMKV = 132 * MiB, WS_WPOOL = 136 * MiB, WS_XY = 138 * MiB, WS_KVS = 202 * MiB, WS_BIG = 298 * MiB, WS_Z = WS_BIG, WS_YCAT = WS_BIG + 64 * MiB, WS_A = WS_BIG, WS_END = 490 * MiB;
constexpr int NTHREADS = 512, LDS_BYTES = 147456;

__device__ __forceinline__ float wave_sum(float v) {
#pragma unroll
    for (int o = 1; o < 64; o <<= 1) v += __shfl_xor(v, o);
    return v;
}
__device__ __forceinline__ unsigned pk2(float lo, float hi) { return pg8::cvt_pk_bf16(lo, hi); }
__device__ __forceinline__ float bflo(unsigned w) { return __uint_as_float(w << 16); }
__device__ __forceinline__ float bfhi(unsigned w) { return __uint_as_float(w & 0xffff0000u); }
#define LDS_WAIT() asm volatile("s_waitcnt lgkmcnt(0)" ::: "memory")

struct Args {
    const float *x, *mem; const int* pos; const float *norm_gains, *mem_norm, *w_in, *w_mem_kv, *w_out, *w_pool, *pool_scale, *kv_norm, *w_kv, *w_gate_up, *w_down;
    float* out; unsigned char* ws;
};

__device__ __forceinline__ int src_col(int mode, int p) {
    if (mode == 1) { const int q = p >> 3, t = p & 7; return (t < 4) ? (4 * q + t) : (DFF + 4 * q + (t - 4)); }
    if (mode == 2 && p < MAINW) { const int hb = p & ~63, j = (p & 63) >> 3, t = p & 7; return hb + ((t < 4) ? (4 * j + t) : (32 + 4 * j + (t - 4))); }
    return p;
}
__device__ __forceinline__ void tr_item(const float* W, int ldw, int K, const float* gain, int mode, bf16* WT, LAS float* scr, int item, int nblk, int lane) {
    const int kb = item / nblk, nb = item % nblk, k0 = 64 * kb, n0 = 32 * nb;
    const int sc = src_col(mode, n0 + (lane & 31));
#pragma unroll 8
    for (int i = 0; i < 32; ++i) { const int kk = 2 * i + (lane >> 5); scr[kk * 33 + (lane & 31)] = W[(size_t)(k0 + kk) * ldw + sc]; }
    LDS_WAIT(); asm volatile("" ::: "memory");
    const int c = lane & 7;
    f32x4 g0 = {1.f, 1.f, 1.f, 1.f}, g1 = g0;
    if (gain) { g0 = *(const f32x4*)(gain + k0 + 8 * c); g1 = *(const f32x4*)(gain + k0 + 8 * c + 4); }
#pragma unroll
    for (int j = 0; j < 4; ++j) { const int n = (lane >> 3) + 8 * j; const LAS float* s = scr + (8 * c) * 33 + n;
        u32x4 o; o.x = pk2(s[0 * 33] * g0[0], s[1 * 33] * g0[1]); o.y = pk2(s[2 * 33] * g0[2], s[3 * 33] * g0[3]); o.z = pk2(s[4 * 33] * g1[0], s[5 * 33] * g1[1]); o.w = pk2(s[6 * 33] * g1[2], s[7 * 33] * g1[3]);
        *(u32x4*)(WT + (size_t)(n0 + n) * K + k0 + 8 * c) = o; }
    LDS_WAIT(); asm volatile("" ::: "memory");
}
__device__ __forceinline__ void row_prep(const float* xrow, bf16* orow, float* rs, int lane) {
    const f32x4* xr = (const f32x4*)xrow + lane; f32x4 v[4]; float s = 0.f;
#pragma unroll
    for (int j = 0; j < 4; ++j) { v[j] = xr[64 * j]; s += (v[j][0] * v[j][0] + v[j][1] * v[j][1]) + (v[j][2] * v[j][2] + v[j][3] * v[j][3]); }
    s = wave_sum(s);
    u32x2* o8 = (u32x2*)orow + lane;
#pragma unroll
    for (int j = 0; j < 4; ++j) { u32x2 w; w.x = pk2(v[j][0], v[j][1]); w.y = pk2(v[j][2], v[j][3]); o8[64 * j] = w; }
    if (lane == 0) *rs = 1.0f / sqrtf(s * (1.f / DM) + EPS);
}
__device__ __forceinline__ void p0_prologue(const Args& A, LAS unsigned char* lds, int tid, int wid, int lane) {
    unsigned char* ws = A.ws;
    LAS float* scr = (LAS float*)(lds + wid * 16384);
    const int gw = blockIdx.x * 8 + wid, NGW = gridDim.x * 8;
    constexpr int I_IN = 16 * 32, I_OUT = 16 * 32, I_GU = 16 * 176, I_DOWN = 44 * 32, I_MKV = 16 * 16, I_L = I_IN + I_OUT + I_GU + I_DOWN + I_MKV, I_KV = 16 * 48, I_POOL = 3 * 6;
    constexpr int NITEMS = 4 * I_L + I_KV + 8 * I_POOL;
    for (int it = gw; it < NITEMS; it += NGW) {
        if (it < 4 * I_L) {
            const int l = it / I_L; int r = it % I_L; unsigned char* wl = ws + WS_W + (size_t)l * WL_STRIDE;
            if (r < I_IN) { tr_item(A.w_in + (size_t)l * DM * DM, DM, DM, A.norm_gains + (l * 4 + 0) * DM, l >= 2 ? 2 : 0, (bf16*)(wl + WL_IN), scr, r, 32, lane); continue; } r -= I_IN;
            if (r < I_OUT) { tr_item(A.w_out + (size_t)l * DM * DM, DM, DM, nullptr, 0, (bf16*)(wl + WL_OUT), scr, r, 32, lane); continue; } r -= I_OUT;
            if (r < I_GU) { tr_item(A.w_gate_up + (size_t)l * DM * 2 * DFF, 2 * DFF, DM, A.norm_gains + (l * 4 + 2) * DM, 1, (bf16*)(wl + WL_GU), scr, r, 176, lane); continue; } r -= I_GU;
            if (r < I_DOWN) { tr_item(A.w_down + (size_t)l * DFF * DM, DM, DFF, nullptr, 0, (bf16*)(wl + WL_DOWN), scr, r, 32, lane); continue; } r -= I_DOWN;
            tr_item(A.w_mem_kv + (size_t)l * DM * 512, 512, DM, A.mem_norm + l * DM, 0, (bf16*)(ws + WS_WMKV) + (size_t)l * 512 * DM, scr, r, 16, lane);
        } else {
            int r = it - 4 * I_L;
            if (r < I_KV) { tr_item(A.w_kv, 2 * MAINW, DM, A.kv_norm, 2, (bf16*)(ws + WS_W + 2 * WL_STRIDE + WL_IN) + (size_t)DM * DM, scr, r, 48, lane); continue; } r -= I_KV;
            const int mi = r / I_POOL; r %= I_POOL;
            tr_item(A.w_pool + (size_t)mi * 192 * 192, 192, 192, nullptr, 0, (bf16*)(ws + WS_WPOOL) + (size_t)mi * 192 * 192, scr, r, 6, lane);
        }
    }
    for (int m = gw; m < MT; m += NGW) row_prep(A.x + (size_t)m * DM, (bf16*)(ws + WS_XY) + (size_t)m * DM, (float*)(ws + WS_RX) + m, lane);
    for (int m = gw; m < MMEM; m += NGW) row_prep(A.mem + (size_t)m * DM, (bf16*)(ws + WS_MEMB) + (size_t)m * DM, (float*)(ws + WS_RMEM) + m, lane);
    const int gt = blockIdx.x * NTHREADS + tid, NGT = gridDim.x * NTHREADS;
    float* rope = (float*)(ws + WS_ROPE);
    for (int it = gt; it < MT * 32; it += NGT) { const int tok = it >> 5, i = it & 31;
        const float freq = exp2f(-(float)i * (13.287712379549449f / 32.f));
        const float ang = (float)A.pos[tok] * freq;
        double t = (double)ang * 0.15915494309189535; t -= rint(t);
        const float rr = (float)(t * 6.283185307179586);
        rope[(size_t)tok * 64 + i] = __cosf(rr); rope[(size_t)tok * 64 + 32 + i] = __sinf(rr); }
}

__device__ __forceinline__ void pool_unit(LAS unsigned char* lds, int u, const bf16* z, const bf16* wpT, const float* scale, bf16* ycat, int tid, int wid, int lane) {
    const int tile = u >> 2, g = u & 3, w = 2 << g, tok0 = tile * 128, s0 = tok0 & (SEQ - 1);
    constexpr int PSTR = 400;
    for (int it = tid; it < 128 * 24; it += NTHREADS) { const int row = it / 24, ch = it % 24, tok = tok0 + row; const int s = s0 + row;
        const int nwin = (s + 1 < w) ? (s + 1) : w;
        float a[8] = {0.f, 0.f, 0.f, 0.f, 0.f, 0.f, 0.f, 0.f};
        const bf16* zp = z + (size_t)tok * DM + g * 192 + ch * 8;
        const u32x4 self = *(const u32x4*)zp;
        for (int k = 0; k < nwin; ++k) { const u32x4 v = *(const u32x4*)(zp - (size_t)k * DM);
            a[0] += bflo(v.x); a[1] += bfhi(v.x); a[2] += bflo(v.y); a[3] += bfhi(v.y); a[4] += bflo(v.z); a[5] += bfhi(v.z); a[6] += bflo(v.w); a[7] += bfhi(v.w); }
        const float inv = 1.0f / (float)nwin;
        u32x4 o; o.x = pk2(a[0] * inv - bflo(self.x), a[1] * inv - bfhi(self.x)); o.y = pk2(a[2] * inv - bflo(self.y), a[3] * inv - bfhi(self.y));
        o.z = pk2(a[4] * inv - bflo(self.z), a[5] * inv - bfhi(self.z)); o.w = pk2(a[6] * inv - bflo(self.w), a[7] * inv - bfhi(self.w));
        *(LAS u32x4*)(lds + row * PSTR + ch * 16) = o; }
    __syncthreads();
    const int fr = lane & 15, fq = lane >> 4;
    f32x4 acc[12];
#pragma unroll
    for (int nt = 0; nt < 12; ++nt) acc[nt] = (f32x4){0.f, 0.f, 0.f, 0.f};
    const bf16* wg = wpT + (size_t)g * 192 * 192 + (size_t)fr * 192 + 8 * fq;
#pragma unroll
    for (int ks = 0; ks < 6; ++ks) { const bf16x8 af = *(const LAS bf16x8*)(lds + (16 * wid + fr) * PSTR + 64 * ks + 16 * fq);
#pragma unroll
        for (int nt = 0; nt < 12; ++nt) { const bf16x8 bfrag = *(const bf16x8*)(wg + (size_t)nt * 16 * 192 + 32 * ks);
            acc[nt] = __builtin_amdgcn_mfma_f32_16x16x32_bf16(bfrag, af, acc[nt], 0, 0, 0); } }
    bf16* orow = ycat + (size_t)(tok0 + 16 * wid + fr) * DM + g * 192 + 4 * fq;
#pragma unroll
    for (int nt = 0; nt < 12; ++nt) { const f32x4 sc = *(const f32x4*)(scale + g * 192 + 16 * nt + 4 * fq); const f32x4 v = acc[nt] * sc;
        u32x2 o; o.x = pk2(v[0], v[1]); o.y = pk2(v[2], v[3]); *(u32x2*)(orow + 16 * nt) = o; }
    __syncthreads();
}

template <int MODE> __device__ __forceinline__ void attn_unit(LAS unsigned char* lds, int u, const bf16* zq, const bf16* kvbase, bf16* ycat, float* lse, int tid, int wid, int lane) {
    constexpr int KSTR = 144, VOFF = 256 * KSTR;
    int b, qcol, d = 1, r = 0, n = 0, gh = 0, qt0 = 0; int kpitch, kcol, vcol;
    if (MODE == 0) { b = u / 192; const int rem = u % 192; gh = rem >> 4; const int rn = rem & 15, g = gh >> 2; d = (g == 0) ? 1 : (g == 1) ? 4 : 16; const int nb = 16 / d; r = rn / nb; n = rn % nb;
        qcol = gh * 64; kpitch = 1536; kcol = gh * 64; vcol = MAINW + gh * 64; }
    else { b = u >> 6; const int rem = u & 63, h = rem >> 4; qt0 = (rem & 15) * 128; qcol = MAINW + h * 64; kpitch = 512; kcol = h * 64; vcol = 256 + h * 64; }
#pragma unroll
    for (int i = 0; i < 4; ++i) { const int idx = tid + NTHREADS * i, row = idx >> 3, ch = idx & 7; size_t tok;
        if (MODE == 0) { int lk = 128 * (n - 1) + row; lk = lk < 0 ? 0 : lk; tok = (size_t)b * SEQ + (size_t)lk * d + r; } else tok = (size_t)b * NMEM + row;
        const bf16* kp = kvbase + tok * kpitch + ch * 8;
        const u32x4 kv = *(const u32x4*)(kp + kcol), vv = *(const u32x4*)(kp + vcol);
        *(LAS u32x4*)(lds + row * KSTR + ch * 16) = kv; *(LAS u32x4*)(lds + VOFF + row * KSTR + ch * 16) = vv; }
    const int fr = lane & 15, fq = lane >> 4;
    const int iq = 16 * wid + fr;
    const size_t qtok = (MODE == 0) ? ((size_t)b * SEQ + (size_t)(128 * n + iq) * d + r) : ((size_t)b * SEQ + qt0 + iq);
    bf16x8 qf[2];
    qf[0] = *(const bf16x8*)(zq + qtok * DM + qcol + 8 * fq); qf[1] = *(const bf16x8*)(zq + qtok * DM + qcol + 32 + 8 * fq);
    __syncthreads();
    constexpr int NT = (MODE == 0) ? 10 : 16;
    const int kt0 = (MODE == 0) ? (wid & ~1) : 0;
    f32x4 s[NT];
#pragma unroll
    for (int kt = 0; kt < NT; ++kt) { const int row = 16 * (kt0 + kt) + fr;
        const bf16x8 a0 = *(const LAS bf16x8*)(lds + row * KSTR + 16 * fq), a1 = *(const LAS bf16x8*)(lds + row * KSTR + 64 + 16 * fq);
        s[kt] = __builtin_amdgcn_mfma_f32_16x16x32_bf16(a0, qf[0], (f32x4){0.f, 0.f, 0.f, 0.f}, 0, 0, 0);
        s[kt] = __builtin_amdgcn_mfma_f32_16x16x32_bf16(a1, qf[1], s[kt], 0, 0, 0); }
    float mx = -3.0e38f;
#pragma unroll
    for (int kt = 0; kt < NT; ++kt)
#pragma unroll
        for (int jj = 0; jj < 4; ++jj) {
            if (MODE == 0) { const int j = 16 * (kt0 + kt) + 4 * fq + jj, rel = iq + 128 - j; const bool ok = (rel >= 0) && (rel <= 128) && (n > 0 || j >= 128); s[kt][jj] = ok ? s[kt][jj] : -1.0e30f; }
            mx = fmaxf(mx, s[kt][jj]); }
    mx = fmaxf(mx, __shfl_xor(mx, 16)); mx = fmaxf(mx, __shfl_xor(mx, 32));
    float sum = 0.f;
#pragma unroll
    for (int kt = 0; kt < NT; ++kt)
#pragma unroll
        for (int jj = 0; jj < 4; ++jj) { const float p = __builtin_amdgcn_exp2f(s[kt][jj] - mx); s[kt][jj] = p; sum += p; }
    sum += __shfl_xor(sum, 16); sum += __shfl_xor(sum, 32);
    f32x4 o[4];
#pragma unroll
    for (int dt = 0; dt < 4; ++dt) o[dt] = (f32x4){0.f, 0.f, 0.f, 0.f};
    const int q4 = (lane & 15) >> 2, p4 = lane & 3;
#pragma unroll
    for (int k = 0; k < NT / 2; ++k) {
        u32x4 pw; pw.x = pk2(s[2 * k][0], s[2 * k][1]); pw.y = pk2(s[2 * k][2], s[2 * k][3]); pw.z = pk2(s[2 * k + 1][0], s[2 * k + 1][1]); pw.w = pk2(s[2 * k + 1][2], s[2 * k + 1][3]);
        const bf16x8 pf = __builtin_bit_cast(bf16x8, pw);
        const int rowb = 16 * kt0 + 32 * k + 4 * fq + q4;
#pragma unroll
        for (int dt = 0; dt < 4; ++dt) { LAS unsigned char* vp = lds + VOFF + rowb * KSTR + (16 * dt + 4 * p4) * 2;
            const v4i16_t lo = __builtin_amdgcn_ds_read_tr16_b64_v4i16((LAS v4i16_t*)vp), hi = __builtin_amdgcn_ds_read_tr16_b64_v4i16((LAS v4i16_t*)(vp + 16 * KSTR));
            const bf16x8 vf = (bf16x8){lo[0], lo[1], lo[2], lo[3], hi[0], hi[1], hi[2], hi[3]};
            o[dt] = __builtin_amdgcn_mfma_f32_16x16x32_bf16(vf, pf, o[dt], 0, 0, 0); } }
    const float inv = 1.0f / sum;
    bf16* op = ycat + qtok * DM + qcol + 4 * fq;
#pragma unroll
    for (int dt = 0; dt < 4; ++dt) { u32x2 w; w.x = pk2(o[dt][0] * inv, o[dt][1] * inv); w.y = pk2(o[dt][2] * inv, o[dt][3] * inv); *(u32x2*)(op + 16 * dt) = w; }
    if (MODE == 0) { if (fq == 0) lse[qtok * 12 + gh] = (mx + __log2f(sum)) * 0.6931471805599453f; }
    __syncthreads();
}

constexpr int STASH_OFF = 131072;
__device__ __forceinline__ unsigned char* ldp(LAS unsigned char* lds, int i) {
    const volatile LAS unsigned* p = (const volatile LAS unsigned*)(lds + STASH_OFF + 8 * i);
    const unsigned lo = __builtin_amdgcn_readfirstlane(p[0]), hi = __builtin_amdgcn_readfirstlane(p[1]);
    return (unsigned char*)(((unsigned long long)hi << 32) | lo);
}
enum { SL_WS = 0, SL_X = 1, SL_OUT = 2, SL_NG = 3, SL_PSC = 4 };
__global__ void __launch_bounds__(NTHREADS, 2) yoco_fwd(Args A) {
    extern __shared__ __attribute__((aligned(16))) unsigned char lds_raw[];
    cg::grid_group grid = cg::this_grid();
    LAS unsigned char* lds = (LAS unsigned char*)lds_raw;
    {
        const int tid = threadIdx.x, lane = tid & 63, wid = __builtin_amdgcn_readfirstlane(tid >> 6);
        if (tid == 0) { LAS unsigned long long* sl = (LAS unsigned long long*)(lds + STASH_OFF);
            sl[SL_WS] = (unsigned long long)A.ws; sl[SL_X] = (unsigned long long)A.x; sl[SL_OUT] = (unsigned long long)A.out; sl[SL_NG] = (unsigned long long)A.norm_gains; sl[SL_PSC] = (unsigned long long)A.pool_scale; }
        p0_prologue(A, lds, tid, wid, lane);
    }
    grid.sync();

    for (int step = -1; step < 16; ++step) {
        const int l = step >> 2, k = (step < 0) ? -1 : (step & 3);
        {
            unsigned char* ws = ldp(lds, SL_WS);
            const unsigned char* wl = ws + WS_W + (size_t)(step < 0 ? 0 : l) * WL_STRIDE;
            bf16* XY = (bf16*)(ws + WS_XY);
            pg8::Gemm g; pg8::EpiAll E; E.rope = (const float*)(ws + WS_ROPE); E.o1 = (bf16*)(ws + WS_KVS); E.rs = (const float*)(ws + WS_RX);
            const int G = gridDim.x;
            if (k == 3) {
                g = pg8::Gemm{(const bf16*)(ws + WS_A), (const bf16*)(wl + WL_DOWN), MT, DM, DFF}; E.kind = 3; E.o0 = XY;
                pg8::StaticOrder S; S.init(g.M, g.N, G, (int)blockIdx.x);
                pg8::gemm_phase<DFF, pg8::EpiAll, pg8::StaticOrder, true, true>(lds, g, S, E);
            } else {
                if (step < 0) { g = pg8::Gemm{(const bf16*)(ws + WS_MEMB), (const bf16*)(ws + WS_WMKV), MMEM, 2048, DM}; E.kind = 2; E.o0 = (bf16*)(ws + WS_KVM); E.rs = (const float*)(ws + WS_RMEM); }
                else if (k == 0) { g = pg8::Gemm{XY, (const bf16*)(wl + WL_IN), MT, (l == 2) ? 2560 : 1024, DM}; E.kind = (l >= 2) ? 1 : 0; E.o0 = (bf16*)(ws + WS_Z); }
                else if (k == 1) { g = pg8::Gemm{(const bf16*)(ws + WS_YCAT), (const bf16*)(wl + WL_OUT), MT, DM, DM}; E.kind = 3; E.o0 = XY; }
                else { g = pg8::Gemm{XY, (const bf16*)(wl + WL_GU), MT, 2 * DFF, DM}; E.kind = 4; E.o0 = (bf16*)(ws + WS_A); }
                pg8::StaticOrder S; S.init(g.M, g.N, G, (int)blockIdx.x);
                pg8::gemm_phase<DM, pg8::EpiAll, pg8::StaticOrder, true, true>(lds, g, S, E);
            }
        }
        if (step < 0) continue;
        grid.sync();
        int tid_ = threadIdx.x; asm volatile("" : "+v"(tid_));
        const int tid = tid_, lane = tid & 63, wid = __builtin_amdgcn_readfirstlane(tid >> 6);
        const int G = gridDim.x;
        unsigned char* ws = ldp(lds, SL_WS);
        bf16* XY = (bf16*)(ws + WS_XY); bf16* Z = (bf16*)(ws + WS_Z); bf16* YCAT = (bf16*)(ws + WS_YCAT); float* LSE = (float*)(ws + WS_LSE);
        if (k == 0) {
            const bf16* kvm_l = (const bf16*)(ws + WS_KVM) + (size_t)l * MMEM * 512;
            if (l < 2) {
                const bf16* wpT = (const bf16*)(ws + WS_WPOOL) + (size_t)l * 4 * 192 * 192; const float* psc = (const float*)ldp(lds, SL_PSC) + l * MAINW;
                for (int u = blockIdx.x; u < 1024 + 1024; u += G) {
                    if (u < 1024) pool_unit(lds, u, Z, wpT, psc, YCAT, tid, wid, lane);
                    else attn_unit<1>(lds, u - 1024, Z, kvm_l, YCAT, LSE, tid, wid, lane);
                }
                grid.sync();
            } else {
                const bf16* KVS = (const bf16*)(ws + WS_KVS);
                for (int u = blockIdx.x; u < 3072 + 1024; u += G) {
                    if (u < 3072) attn_unit<0>(lds, u, Z, KVS, YCAT, LSE, tid, wid, lane);
                    else attn_unit<1>(lds, u - 3072, Z, kvm_l, YCAT, LSE, tid, wid, lane);
                }
                grid.sync();
                const int gt = blockIdx.x * NTHREADS + tid, NGT = G * NTHREADS;
                for (int it = gt; it < MT * 96; it += NGT) { const int tok = it / 96, ch = it % 96, head = ch >> 3, gg = head >> 2, h = head & 3;
                    const float l0 = LSE[(size_t)tok * 12 + h], l1 = LSE[(size_t)tok * 12 + 4 + h], l2 = LSE[(size_t)tok * 12 + 8 + h];
                    const float m = fmaxf(l0, fmaxf(l1, l2)); const float e0 = __expf(l0 - m), e1 = __expf(l1 - m), e2 = __expf(l2 - m);
                    const float al = ((gg == 0) ? e0 : (gg == 1) ? e1 : e2) / (e0 + e1 + e2);
                    u32x4* p = (u32x4*)(YCAT + (size_t)tok * DM + ch * 8); const u32x4 v = *p; u32x4 o;
                    o.x = pk2(bflo(v.x) * al, bfhi(v.x) * al); o.y = pk2(bflo(v.y) * al, bfhi(v.y) * al); o.z = pk2(bflo(v.z) * al, bfhi(v.z) * al); o.w = pk2(bflo(v.w) * al, bfhi(v.w) * al); *p = o; }
                grid.sync();
            }
        } else if (k == 1 || k == 3) {
            const int gw = blockIdx.x * 8 + wid, NGW = G * 8;
            float* out = (float*)ldp(lds, SL_OUT);
            const float* xs = (step == 1) ? (const float*)ldp(lds, SL_X) : out; const float* gain = (const float*)ldp(lds, SL_NG) + (l * 4 + k) * DM;
            float* RX = (float*)(ws + WS_RX);
            for (int m = gw; m < MT; m += NGW) {
                const f32x4* xr = (const f32x4*)(xs + (size_t)m * DM) + lane; u32x2* yr = (u32x2*)(XY + (size_t)m * DM) + lane; f32x4* orow = (f32x4*)(out + (size_t)m * DM) + lane;
                u32x2 yy[4]; float sy = 0.f;
#pragma unroll
                for (int j = 0; j < 4; ++j) { yy[j] = yr[64 * j]; const float a = bflo(yy[j].x), b = bfhi(yy[j].x), c = bflo(yy[j].y), d = bfhi(yy[j].y); sy += (a * a + b * b) + (c * c + d * d); }
                sy = wave_sum(sy);
                const float ry = 1.0f / sqrtf(sy * (1.f / DM) + EPS); float s = 0.f; f32x4 v[4];
#pragma unroll
                for (int j = 0; j < 4; ++j) { const f32x4 xv = xr[64 * j]; const u32x2 yv = yy[j]; const f32x4 gv = *((const f32x4*)gain + lane + 64 * j);
                    v[j][0] = xv[0] + bflo(yv.x) * ry * gv[0]; v[j][1] = xv[1] + bfhi(yv.x) * ry * gv[1]; v[j][2] = xv[2] + bflo(yv.y) * ry * gv[2]; v[j][3] = xv[3] + bfhi(yv.y) * ry * gv[3];
                    s += (v[j][0] * v[j][0] + v[j][1] * v[j][1]) + (v[j][2] * v[j][2] + v[j][3] * v[j][3]); }
                s = wave_sum(s);
#pragma unroll
                for (int j = 0; j < 4; ++j) { orow[64 * j] = v[j]; u32x2 w; w.x = pk2(v[j][0], v[j][1]); w.y = pk2(v[j][2], v[j][3]); yr[64 * j] = w; }
                if (lane == 0) RX[m] = 1.0f / sqrtf(s * (1.f / DM) + EPS);
            }
            grid.sync();
        }
    }
}

extern "C" void kernel_launch(void* const* d_in, const int* in_sizes, int n_in, void* d_out, int out_size, void* d_ws, size_t ws_size, hipStream_t stream) {
    static int grid = 0;
    if (grid == 0) {
        if (n_in != 14 || out_size != MT * DM || ws_size < WS_END) { fprintf(stderr, "kernel_launch: unexpected shapes (n_in %d, out %d, ws %zu)\n", n_in, out_size, ws_size); grid = -1; return; }
        int dev = 0, cus = 0, per_cu = 0;
        (void)hipGetDevice(&dev); (void)hipDeviceGetAttribute(&cus, hipDeviceAttributeMultiprocessorCount, dev);
        (void)hipFuncSetAttribute((const void*)yoco_fwd, hipFuncAttributeMaxDynamicSharedMemorySize, LDS_BYTES);
        (void)hipOccupancyMaxActiveBlocksPerMultiprocessor(&per_cu, (const void*)yoco_fwd, NTHREADS, LDS_BYTES);
        if (per_cu < 1) per_cu = 1;
        grid = cus * per_cu;
    }
    if (grid < 0) return;
    Args a{};
    a.x = (const float*)d_in[0]; a.mem = (const float*)d_in[1]; a.pos = (const int*)d_in[2]; a.norm_gains = (const float*)d_in[3]; a.mem_norm = (const float*)d_in[4];
    a.w_in = (const float*)d_in[5]; a.w_mem_kv = (const float*)d_in[6]; a.w_out = (const float*)d_in[7]; a.w_pool = (const float*)d_in[8]; a.pool_scale = (const float*)d_in[9];
    a.kv_norm = (const float*)d_in[10]; a.w_kv = (const float*)d_in[11]; a.w_gate_up = (const float*)d_in[12]; a.w_down = (const float*)d_in[13];
    a.out = (float*)d_out; a.ws = (unsigned char*)d_ws;
    void* args[] = {&a};
    hipError_t e = hipLaunchCooperativeKernel((const void*)yoco_fwd, dim3(grid), dim3(NTHREADS), args, LDS_BYTES, stream);
    if (e != hipSuccess) fprintf(stderr, "kernel_launch: cooperative launch failed: %s (grid %d)\n", hipGetErrorString(e), grid);
}
```

```cpp
#include <hip/hip_runtime.h>
#include <hip/hip_cooperative_groups.h>
#include <cstdio>
#include <cstdint>
namespace cg = cooperative_groups;
namespace pg8 {
#define PG8_LAS __attribute__((address_space(3)))
typedef unsigned short bf16_t;
typedef short bf16x8 __attribute__((ext_vector_type(8)));
typedef float f32x4 __attribute__((ext_vector_type(4)));
typedef unsigned u32x4 __attribute__((ext_vector_type(4)));
constexpr int BM = 256, BK = 64, HALF = 128, HTB = HALF * BK * 2  , STAGE_BYTES = 8 * HTB, NXCD = 8, WGM = 8;

__host__ __device__ __forceinline__ int lds_byte(int r, int c) { const int st = (r >> 4) * 2 + (c >> 5), rr = r & 15, cc = c & 31, ob = rr * 64 + cc * 2; return st * 1024 + (ob ^ (((ob >> 9) & 1) << 5)); }
__host__ __device__ __forceinline__ void stage_rc(int b, int& R, int& C) { const int st = b / 1024, sb = b % 1024, swz = sb ^ (((sb >> 9) & 1) << 5); R = (st >> 1) * 16 + swz / 64; C = (st & 1) * 32 + (swz % 64) / 2; }
__host__ __device__ __forceinline__ int perm32(int rho) { const int n = rho >> 4, i = rho & 15; return 8 * (i >> 2) + 4 * n + (i & 3); }

struct Unit { int pm, pn; };
struct Gemm { const bf16_t* A; const bf16_t* Bt; int M, N, K; };

struct StaticOrder {
    int nM, nN, nwg, G, c;
    __host__ __device__ void init(int M, int N, int G_, int c_) { nM = M / BM; nN = N / BM; nwg = nM * nN; G = G_; c = c_; }
    __host__ __device__ bool next(int i, Unit& u) const {
        const long L = (long)i * G + c; if (L >= nwg) return false;
        int wgid = (int)L; { const int q = nwg / NXCD, r = nwg % NXCD, xcd = wgid % NXCD, off = wgid / NXCD; wgid = (xcd < r ? xcd * (q + 1) : r * (q + 1) + (xcd - r) * q) + off; }
        const int nig = WGM * nN, gid = wgid / nig, fm = gid * WGM, gsz = (nM - fm) < WGM ? (nM - fm) : WGM;
        u.pm = fm + ((wgid % nig) % gsz); u.pn = (wgid % nig) / gsz; return true;
    }
    __device__ __forceinline__ void a_ready(const Unit&) const {}
    __device__ __forceinline__ void done(const Unit&) const {}
};

__device__ __forceinline__ unsigned cvt_pk_bf16(float lo, float hi) { unsigned r; asm volatile("v_cvt_pk_bf16_f32 %0, %1, %2" : "=v"(r) : "v"(lo), "v"(hi)); return r; }
constexpr float C2 = 0.125f * 1.4426950408889634f;
struct EpiAll {
    static constexpr bool PERM = true, AFTER_DRAIN = false;
    int kind; bf16_t* o0; bf16_t* o1; const float* rs; const float* rope;
    __device__ __forceinline__ void operator()(const f32x4 (&acc)[2][2][4][2], const Unit& u, int wr, int wc, int fr, int fq) const {
        const int row0 = u.pm * BM + wr * 64 + fr;
        if (kind <= 2) {
            bf16_t* base; int ldc, colt; bool rp = false; float sc = 1.f;
            if (kind == 0) { base = o0; ldc = 1024; colt = u.pn * 256; if (u.pn == 3) sc = C2; }
            else if (kind == 1) { if (u.pn < 4) { base = o0; ldc = 1024; colt = u.pn * 256; rp = u.pn < 3; sc = C2; } else { base = o1; ldc = 1536; colt = u.pn * 256 - 1024; rp = u.pn < 7; } }
            else { base = o0 + (size_t)(u.pn >> 1) * 4096 * 512; ldc = 512; colt = (u.pn & 1) * 256; }
#pragma unroll
            for (int ai = 0; ai < 2; ++ai)
#pragma unroll
                for (int m = 0; m < 4; ++m) { const int r = row0 + ai * HALF + m * 16; const float rsv = rs[r] * sc;
#pragma unroll
                    for (int bj = 0; bj < 2; ++bj) { const int c = colt + bj * HALF + wc * 32 + fq * 8;
                        f32x4 v0 = acc[ai][bj][m][0] * rsv, v1 = acc[ai][bj][m][1] * rsv;
                        if (rp) { const int j = (c & 63) >> 3; const f32x4 cs = *(const f32x4*)(rope + (size_t)r * 64 + 4 * j), sn = *(const f32x4*)(rope + (size_t)r * 64 + 32 + 4 * j);
                            const f32x4 a = v0 * cs - v1 * sn, b = v0 * sn + v1 * cs; v0 = a; v1 = b; }
                        u32x4 w; w.x = cvt_pk_bf16(v0[0], v0[1]); w.y = cvt_pk_bf16(v0[2], v0[3]); w.z = cvt_pk_bf16(v1[0], v1[1]); w.w = cvt_pk_bf16(v1[2], v1[3]);
                        *(u32x4*)(base + (size_t)r * ldc + c) = w; } }
        } else if (kind == 3) {
#pragma unroll
            for (int ai = 0; ai < 2; ++ai)
#pragma unroll
                for (int m = 0; m < 4; ++m) { const int r = row0 + ai * HALF + m * 16;
#pragma unroll
                    for (int bj = 0; bj < 2; ++bj) { const int c = u.pn * 256 + bj * HALF + wc * 32 + fq * 8;
                        const f32x4 v0 = acc[ai][bj][m][0], v1 = acc[ai][bj][m][1];
                        u32x4 w; w.x = cvt_pk_bf16(v0[0], v0[1]); w.y = cvt_pk_bf16(v0[2], v0[3]); w.z = cvt_pk_bf16(v1[0], v1[1]); w.w = cvt_pk_bf16(v1[2], v1[3]);
                        *(u32x4*)(o0 + (size_t)r * 1024 + c) = w; } }
        } else {
            typedef unsigned u32x2 __attribute__((ext_vector_type(2)));
#pragma unroll
            for (int ai = 0; ai < 2; ++ai)
#pragma unroll
                for (int m = 0; m < 4; ++m) { const int r = row0 + ai * HALF + m * 16; const float rsv = rs[r];
#pragma unroll
                    for (int bj = 0; bj < 2; ++bj) { const int c = u.pn * 128 + bj * 64 + wc * 16 + fq * 4;
                        const f32x4 g = acc[ai][bj][m][0] * rsv, up = acc[ai][bj][m][1] * rsv; f32x4 h;
#pragma unroll
                        for (int t = 0; t < 4; ++t) h[t] = g[t] * __builtin_amdgcn_rcpf(1.f + __builtin_amdgcn_exp2f(-1.4426950408889634f * g[t])) * up[t];
                        u32x2 w; w.x = cvt_pk_bf16(h[0], h[1]); w.y = cvt_pk_bf16(h[2], h[3]);
                        *(u32x2*)(o0 + (size_t)r * 2816 + c) = w; } }
        }
    }
};

template <int KC, class Epi, class Sched, bool ALIGN_EPI = false, bool SP2 = false>
__device__ __forceinline__ void gemm_phase(PG8_LAS unsigned char* lds, const Gemm g, const Sched& S, const Epi& E) {
    int tid_ = threadIdx.x; asm volatile("" : "+v"(tid_));
    const int tid = tid_, wid = __builtin_amdgcn_readfirstlane(tid >> 6), lane = tid & 63, wr = wid >> 2, wc = wid & 3, fr = lane & 15, fq = lane >> 4;
    constexpr int K = KC, nt = K / BK;
    unsigned voffA[2], voffB[2];
#pragma unroll
    for (int i = 0; i < 2; ++i) { int R, C; stage_rc(tid * 16 + i * 8192, R, C); const int Rb = Epi::PERM ? ((R & ~31) + perm32(R & 31)) : R;
        voffA[i] = (unsigned)(R * K + C) * 2u; voffB[i] = (unsigned)(Rb * K + C) * 2u; }
    const size_t kstep = (size_t)(BK * 2);
    const size_t hstep = (size_t)HALF * K * 2;
    const size_t tstep = 2 * hstep;
    const unsigned ldsw = (unsigned)wid * 1024u;
    const int aoff = lds_byte(wr * 64 + fr, fq * 8), boff = lds_byte(wc * 32 + fr, fq * 8);
#define PG8_SA(b, h) (((b) * 2 + (h)) * HTB)
#define PG8_SB(b, h) ((4 + (b) * 2 + (h)) * HTB)
#define PG8_STAGE(bufoff, gbase, voff) do { _Pragma("unroll") for (int _i = 0; _i < 2; ++_i) \
        __builtin_amdgcn_global_load_lds((const unsigned*)((const char*)(gbase) + (voff)[_i]), (PG8_LAS unsigned*)(lds + (bufoff) + ldsw + _i * 8192), 16, 0, 0); } while (0)
#define PG8_LDA(dst, b, h) do { _Pragma("unroll") for (int m = 0; m < 4; ++m) _Pragma("unroll") for (int k = 0; k < 2; ++k) dst[m][k] = *(const PG8_LAS bf16x8*)(lds + PG8_SA(b, h) + aoff + m * 2048 + k * 1024); } while (0)
#define PG8_LDB(dst, b, h) do { _Pragma("unroll") for (int n = 0; n < 2; ++n) _Pragma("unroll") for (int k = 0; k < 2; ++k) dst[n][k] = *(const PG8_LAS bf16x8*)(lds + PG8_SB(b, h) + boff + n * 2048 + k * 1024); } while (0)
#define PG8_MMA(ai, bj, At, Bt) do { __builtin_amdgcn_s_setprio(1); _Pragma("unroll") for (int m = 0; m < 4; ++m) _Pragma("unroll") for (int n = 0; n < 2; ++n) _Pragma("unroll") for (int k = 0; k < 2; ++k) \
        acc[ai][bj][m][n] = __builtin_amdgcn_mfma_f32_16x16x32_bf16(Bt[n][k], At[m][k], acc[ai][bj][m][n], 0, 0, 0); __builtin_amdgcn_s_setprio(0); } while (0)
#define PG8_WAIT_V(n) asm volatile("s_waitcnt vmcnt(" #n ")" ::: "memory")
#define PG8_WAIT_L(n) asm volatile("s_waitcnt lgkmcnt(" #n ")" ::: "memory")
#define PG8_BAR __builtin_amdgcn_s_barrier()
#define PG8_SCHED __builtin_amdgcn_sched_barrier(0)
    Unit cur, nxt; int ui = 0;
    if (!S.next(0, cur)) return;
    f32x4 acc[2][2][4][2];
#pragma unroll
    for (int a = 0; a < 2; ++a)
#pragma unroll
        for (int b = 0; b < 2; ++b)
#pragma unroll
            for (int m = 0; m < 4; ++m)
#pragma unroll
                for (int n = 0; n < 2; ++n) acc[a][b][m][n] = (f32x4){0.f, 0.f, 0.f, 0.f};
    bf16x8 At[4][2], B0[2][2], B1[2][2];
    const char* cA = (const char*)g.A + (size_t)cur.pm * tstep; const char* cB = (const char*)g.Bt + (size_t)cur.pn * tstep;
    S.a_ready(cur);
    if constexpr (SP2) {
        PG8_STAGE(PG8_SB(0, 0), cB, voffB); PG8_STAGE(PG8_SB(0, 1), cB + hstep, voffB); PG8_STAGE(PG8_SA(0, 0), cA, voffA); PG8_STAGE(PG8_SA(0, 1), cA + hstep, voffA);
        if (wr == 1) PG8_BAR;
        PG8_WAIT_V(2); PG8_BAR;
        PG8_STAGE(PG8_SB(1, 0), cB + kstep, voffB); PG8_STAGE(PG8_SA(1, 0), cA + kstep, voffA); PG8_STAGE(PG8_SB(1, 1), cB + hstep + kstep, voffB);
        PG8_WAIT_V(6); PG8_BAR;
    } else {
        PG8_STAGE(PG8_SB(0, 0), cB, voffB); PG8_STAGE(PG8_SA(0, 0), cA, voffA); PG8_STAGE(PG8_SB(0, 1), cB + hstep, voffB); PG8_STAGE(PG8_SA(0, 1), cA + hstep, voffA);
        if (wr == 1) PG8_BAR;
        PG8_WAIT_V(4); PG8_BAR;
        PG8_STAGE(PG8_SB(1, 0), cB + kstep, voffB); PG8_STAGE(PG8_SA(1, 0), cA + kstep, voffA); PG8_STAGE(PG8_SB(1, 1), cB + hstep + kstep, voffB);
        PG8_WAIT_V(6); PG8_BAR;
    }
    for (;;) {
        const bool has_next = S.next(ui + 1, nxt);
        const char* nA = has_next ? (const char*)g.A + (size_t)nxt.pm * tstep : cA; const char* nB = has_next ? (const char*)g.Bt + (size_t)nxt.pn * tstep : cB;
        for (int t = 0; t < nt; t += 2) {
            const bool last = (t == nt - 2);
            const char* a1 = cA + (size_t)(t + 1) * kstep;
            const char* a2 = last ? nA : cA + (size_t)(t + 2) * kstep; const char* b2 = last ? nB : cB + (size_t)(t + 2) * kstep;
            const char* a3 = a2 + kstep; const char* b3 = b2 + kstep;
            if (last && has_next) S.a_ready(nxt);
            if constexpr (SP2) {
            PG8_LDB(B0, 0, 0); PG8_LDB(B1, 0, 1); PG8_SCHED; PG8_LDA(At, 0, 0); PG8_STAGE(PG8_SA(1, 1), a1 + hstep, voffA);
            PG8_WAIT_V(8); PG8_WAIT_L(0); PG8_BAR; PG8_MMA(0, 0, At, B0); PG8_MMA(0, 1, At, B1); PG8_BAR; PG8_SCHED;
            PG8_LDA(At, 0, 1); PG8_STAGE(PG8_SB(0, 0), b2, voffB); PG8_STAGE(PG8_SB(0, 1), b2 + hstep, voffB); PG8_STAGE(PG8_SA(0, 0), a2, voffA);
            PG8_WAIT_V(8); PG8_WAIT_L(0); PG8_BAR; PG8_MMA(1, 0, At, B0); PG8_MMA(1, 1, At, B1); PG8_BAR; PG8_SCHED;
            PG8_LDB(B0, 1, 0); PG8_LDB(B1, 1, 1); PG8_SCHED; PG8_LDA(At, 1, 0); PG8_STAGE(PG8_SA(0, 1), a2 + hstep, voffA);
            PG8_WAIT_V(8); PG8_WAIT_L(0); PG8_BAR; PG8_MMA(0, 0, At, B0); PG8_MMA(0, 1, At, B1); PG8_BAR; PG8_SCHED;
            PG8_LDA(At, 1, 1); PG8_STAGE(PG8_SB(1, 0), b3, voffB); PG8_STAGE(PG8_SB(1, 1), b3 + hstep, voffB); PG8_STAGE(PG8_SA(1, 0), a3, voffA);
            PG8_WAIT_V(8); PG8_WAIT_L(0); PG8_BAR; PG8_MMA(1, 0, At, B0); PG8_MMA(1, 1, At, B1); PG8_BAR; PG8_SCHED;
            } else {
            PG8_LDB(B0, 0, 0); PG8_SCHED; PG8_LDA(At, 0, 0); PG8_STAGE(PG8_SA(1, 1), a1 + hstep, voffA);
            PG8_WAIT_L(8); PG8_BAR; PG8_WAIT_L(0); PG8_MMA(0, 0, At, B0); PG8_BAR; PG8_SCHED;
            PG8_LDB(B1, 0, 1); PG8_STAGE(PG8_SB(0, 0), b2, voffB);
            PG8_BAR; PG8_WAIT_L(0); PG8_MMA(0, 1, At, B1); PG8_BAR;
            PG8_LDA(At, 0, 1); PG8_STAGE(PG8_SA(0, 0), a2, voffA);
            PG8_BAR; PG8_WAIT_L(0); PG8_MMA(1, 0, At, B0); PG8_BAR; PG8_SCHED;
            PG8_STAGE(PG8_SB(0, 1), b2 + hstep, voffB);
            PG8_WAIT_V(6); PG8_BAR; PG8_MMA(1, 1, At, B1); PG8_BAR;
            PG8_LDB(B0, 1, 0); PG8_SCHED; PG8_LDA(At, 1, 0); PG8_STAGE(PG8_SA(0, 1), a2 + hstep, voffA);
            PG8_WAIT_L(8); PG8_BAR; PG8_WAIT_L(0); PG8_MMA(0, 0, At, B0); PG8_BAR; PG8_SCHED;
            PG8_LDB(B1, 1, 1); PG8_STAGE(PG8_SB(1, 0), b3, voffB);
            PG8_BAR; PG8_WAIT_L(0); PG8_MMA(0, 1, At, B1); PG8_BAR;
            PG8_LDA(At, 1, 1); PG8_STAGE(PG8_SA(1, 0), a3, voffA);
            PG8_BAR; PG8_WAIT_L(0); PG8_MMA(1, 0, At, B0); PG8_BAR; PG8_SCHED;
            PG8_STAGE(PG8_SB(1, 1), b3 + hstep, voffB);
            PG8_WAIT_V(6); PG8_BAR; PG8_MMA(1, 1, At, B1); PG8_BAR;
            }
        }
        if constexpr (ALIGN_EPI) { if (wr == 0) PG8_BAR; }
        if constexpr (!Epi::AFTER_DRAIN) { E(acc, cur, wr, wc, fr, fq); S.done(cur); }
        if (!has_next) break;
#pragma unroll
        for (int a = 0; a < 2; ++a)
#pragma unroll
            for (int b = 0; b < 2; ++b)
#pragma unroll
                for (int m = 0; m < 4; ++m)
#pragma unroll
                    for (int n = 0; n < 2; ++n) acc[a][b][m][n] = (f32x4){0.f, 0.f, 0.f, 0.f};
        cur = nxt; cA = nA; cB = nB; ++ui;
        if constexpr (ALIGN_EPI) { if (wr == 1) PG8_BAR; }
    }
    PG8_WAIT_V(0);
    if constexpr (!ALIGN_EPI) { if (wr == 0) PG8_BAR; }
    PG8_BAR;
    if constexpr (Epi::AFTER_DRAIN) { E.fused(acc, cur, wr, wc, fr, fq, lds, wid, lane); S.done(cur); }
#undef PG8_SA
#undef PG8_SB
#undef PG8_STAGE
#undef PG8_LDA
#undef PG8_LDB
#undef PG8_MMA
#undef PG8_WAIT_V
#undef PG8_WAIT_L
#undef PG8_BAR
#undef PG8_SCHED
}
}
#define LAS __attribute__((address_space(3)))
typedef unsigned short bf16;
typedef float f32x4 __attribute__((ext_vector_type(4)));
typedef short bf16x8 __attribute__((ext_vector_type(8)));
typedef unsigned u32x4 __attribute__((ext_vector_type(4)));
typedef unsigned u32x2 __attribute__((ext_vector_type(2)));
typedef short v4i16_t __attribute__((ext_vector_type(4)));
constexpr int DM = 1024, NB = 16, SEQ = 2048, MT = NB * SEQ, NMEM = 256, MMEM = NB * NMEM, DFF = 2816, MAINW = 768;
constexpr float EPS = 1e-6f;
constexpr size_t MiB = 1u << 20;
constexpr size_t WS_SSQ = 0, WS_RX = 1 * MiB, WS_RMEM = 1 * MiB + 256 * 1024, WS_LSE = 2 * MiB, WS_ROPE = 4 * MiB, WS_MEMB = 12 * MiB, WS_KVM = 20 * MiB;
constexpr size_t WS_W = 36 * MiB, WL_STRIDE = 24 * MiB, WL_IN = 0, WL_OUT = 5 * MiB, WL_GU = 7 * MiB, WL_DOWN = 18 * MiB;
constexpr size_t WS_WMKV = 132 * MiB, WS_WPOOL = 136 * MiB, WS_XY = 138 * MiB, WS_KVS = 202 * MiB, WS_BIG = 298 * MiB, WS_Z = WS_BIG, WS_YCAT = WS_BIG + 64 * MiB, WS_A = WS_BIG, WS_END = 490 * MiB;
constexpr int NTHREADS = 512, LDS_BYTES = 147456;

__device__ __forceinline__ float wave_sum(float v) {
#pragma unroll
    for (int o = 1; o < 64; o <<= 1) v += __shfl_xor(v, o);
    return v;
}
__device__ __forceinline__ unsigned pk2(float lo, float hi) { return pg8::cvt_pk_bf16(lo, hi); }
__device__ __forceinline__ float bflo(unsigned w) { return __uint_as_float(w << 16); }
__device__ __forceinline__ float bfhi(unsigned w) { return __uint_as_float(w & 0xffff0000u); }
#define LDS_WAIT() asm volatile("s_waitcnt lgkmcnt(0)" ::: "memory")

struct Args {
    const float *x, *mem; const int* pos; const float *norm_gains, *mem_norm, *w_in, *w_mem_kv, *w_out, *w_pool, *pool_scale, *kv_norm, *w_kv, *w_gate_up, *w_down;
    float* out; unsigned char* ws;
};

__device__ __forceinline__ int src_col(int mode, int p) {
    if (mode == 1) { const int q = p >> 3, t = p & 7; return (t < 4) ? (4 * q + t) : (DFF + 4 * q + (t - 4)); }
    if (mode == 2 && p < MAINW) { const int hb = p & ~63, j = (p & 63) >> 3, t = p & 7; return hb + ((t < 4) ? (4 * j + t) : (32 + 4 * j + (t - 4))); }
    return p;
}
__device__ __forceinline__ void tr_item(const float* W, int ldw, int K, const float* gain, int mode, bf16* WT, LAS float* scr, int item, int nblk, int lane) {
    const int kb = item / nblk, nb = item % nblk, k0 = 64 * kb, n0 = 32 * nb;
    const int sc = src_col(mode, n0 + (lane & 31));
#pragma unroll 8
    for (int i = 0; i < 32; ++i) { const int kk = 2 * i + (lane >> 5); scr[kk * 33 + (lane & 31)] = W[(size_t)(k0 + kk) * ldw + sc]; }
    LDS_WAIT(); asm volatile("" ::: "memory");
    const int c = lane & 7;
    f32x4 g0 = {1.f, 1.f, 1.f, 1.f}, g1 = g0;
    if (gain) { g0 = *(const f32x4*)(gain + k0 + 8 * c); g1 = *(const f32x4*)(gain + k0 + 8 * c + 4); }
#pragma unroll
    for (int j = 0; j < 4; ++j) { const int n = (lane >> 3) + 8 * j; const LAS float* s = scr + (8 * c) * 33 + n;
        u32x4 o; o.x = pk2(s[0 * 33] * g0[0], s[1 * 33] * g0[1]); o.y = pk2(s[2 * 33] * g0[2], s[3 * 33] * g0[3]); o.z = pk2(s[4 * 33] * g1[0], s[5 * 33] * g1[1]); o.w = pk2(s[6 * 33] * g1[2], s[7 * 33] * g1[3]);
        *(u32x4*)(WT + (size_t)(n0 + n) * K + k0 + 8 * c) = o; }
    LDS_WAIT(); asm volatile("" ::: "memory");
}
__device__ __forceinline__ void row_prep(const float* xrow, bf16* orow, float* rs, int lane) {
    const f32x4* xr = (const f32x4*)xrow + lane; f32x4 v[4]; float s = 0.f;
#pragma unroll
    for (int j = 0; j < 4; ++j) { v[j] = xr[64 * j]; s += (v[j][0] * v[j][0] + v[j][1] * v[j][1]) + (v[j][2] * v[j][2] + v[j][3] * v[j][3]); }
    s = wave_sum(s);
    u32x2* o8 = (u32x2*)orow + lane;
#pragma unroll
    for (int j = 0; j < 4; ++j) { u32x2 w; w.x = pk2(v[j][0], v[j][1]); w.y = pk2(v[j][2], v[j][3]); o8[64 * j] = w; }
    if (lane == 0) *rs = 1.0f / sqrtf(s * (1.f / DM) + EPS);
}
__device__ __forceinline__ void p0_prologue(const Args& A, LAS unsigned char* lds, int tid, int wid, int lane) {
    unsigned char* ws = A.ws;
    LAS float* scr = (LAS float*)(lds + wid * 16384);
    const int gw = blockIdx.x * 8 + wid, NGW = gridDim.x * 8;
    constexpr int I_IN = 16 * 32, I_OUT = 16 * 32, I_GU = 16 * 176, I_DOWN = 44 * 32, I_MKV = 16 * 16, I_L = I_IN + I_OUT + I_GU + I_DOWN + I_MKV, I_KV = 16 * 48, I_POOL = 3 * 6;
    constexpr int NITEMS = 4 * I_L + I_KV + 8 * I_POOL;
    for (int it = gw; it < NITEMS; it += NGW) {
        if (it < 4 * I_L) {
            const int l = it / I_L; int r = it % I_L; unsigned char* wl = ws + WS_W + (size_t)l * WL_STRIDE;
            if (r < I_IN) { tr_item(A.w_in + (size_t)l * DM * DM, DM, DM, A.norm_gains + (l * 4 + 0) * DM, l >= 2 ? 2 : 0, (bf16*)(wl + WL_IN), scr, r, 32, lane); continue; } r -= I_IN;
            if (r < I_OUT) { tr_item(A.w_out + (size_t)l * DM * DM, DM, DM, nullptr, 0, (bf16*)(wl + WL_OUT), scr, r, 32, lane); continue; } r -= I_OUT;
            if (r < I_GU) { tr_item(A.w_gate_up + (size_t)l * DM * 2 * DFF, 2 * DFF, DM, A.norm_gains + (l * 4 + 2) * DM, 1, (bf16*)(wl + WL_GU), scr, r, 176, lane); continue; } r -= I_GU;
            if (r < I_DOWN) { tr_item(A.w_down + (size_t)l * DFF * DM, DM, DFF, nullptr, 0, (bf16*)(wl + WL_DOWN), scr, r, 32, lane); continue; } r -= I_DOWN;
            tr_item(A.w_mem_kv + (size_t)l * DM * 512, 512, DM, A.mem_norm + l * DM, 0, (bf16*)(ws + WS_WMKV) + (size_t)l * 512 * DM, scr, r, 16, lane);
        } else {
            int r = it - 4 * I_L;
            if (r < I_KV) { tr_item(A.w_kv, 2 * MAINW, DM, A.kv_norm, 2, (bf16*)(ws + WS_W + 2 * WL_STRIDE + WL_IN) + (size_t)DM * DM, scr, r, 48, lane); continue; } r -= I_KV;
            const int mi = r / I_POOL; r %= I_POOL;
            tr_item(A.w_pool + (size_t)mi * 192 * 192, 192, 192, nullptr, 0, (bf16*)(ws + WS_WPOOL) + (size_t)mi * 192 * 192, scr, r, 6, lane);
        }
    }
    for (int m = gw; m < MT; m += NGW) row_prep(A.x + (size_t)m * DM, (bf16*)(ws + WS_XY) + (size_t)m * DM, (float*)(ws + WS_RX) + m, lane);
    for (int m = gw; m < MMEM; m += NGW) row_prep(A.mem + (size_t)m * DM, (bf16*)(ws + WS_MEMB) + (size_t)m * DM, (float*)(ws + WS_RMEM) + m, lane);
    const int gt = blockIdx.x * NTHREADS + tid, NGT = gridDim.x * NTHREADS;
    float* rope = (float*)(ws + WS_ROPE);
    for (int it = gt; it < MT * 32; it += NGT) { const int tok = it >> 5, i = it & 31;
        const float freq = exp2f(-(float)i * (13.287712379549449f / 32.f));
        const float ang = (float)A.pos[tok] * freq;
        double t = (double)ang * 0.15915494309189535; t -= rint(t);
        const float rr = (float)(t * 6.283185307179586);
        rope[(size_t)tok * 64 + i] = __cosf(rr); rope[(size_t)tok * 64 + 32 + i] = __sinf(rr); }
}

__device__ __forceinline__ void pool_unit(LAS unsigned char* lds, int u, const bf16* z, const bf16* wpT, const float* scale, bf16* ycat, int tid, int wid, int lane) {
    const int tile = u >> 2, g = u & 3, w = 2 << g, tok0 = tile * 128, s0 = tok0 & (SEQ - 1);
    constexpr int PSTR = 400;
    for (int it = tid; it < 128 * 24; it += NTHREADS) { const int row = it / 24, ch = it % 24, tok = tok0 + row; const int s = s0 + row;
        const int nwin = (s + 1 < w) ? (s + 1) : w;
        float a[8] = {0.f, 0.f, 0.f, 0.f, 0.f, 0.f, 0.f, 0.f};
        const bf16* zp = z + (size_t)tok * DM + g * 192 + ch * 8;
        const u32x4 self = *(const u32x4*)zp;
        for (int k = 0; k < nwin; ++k) { const u32x4 v = *(const u32x4*)(zp - (size_t)k * DM);
            a[0] += bflo(v.x); a[1] += bfhi(v.x); a[2] += bflo(v.y); a[3] += bfhi(v.y); a[4] += bflo(v.z); a[5] += bfhi(v.z); a[6] += bflo(v.w); a[7] += bfhi(v.w); }
        const float inv = 1.0f / (float)nwin;
        u32x4 o; o.x = pk2(a[0] * inv - bflo(self.x), a[1] * inv - bfhi(self.x)); o.y = pk2(a[2] * inv - bflo(self.y), a[3] * inv - bfhi(self.y));
        o.z = pk2(a[4] * inv - bflo(self.z), a[5] * inv - bfhi(self.z)); o.w = pk2(a[6] * inv - bflo(self.w), a[7] * inv - bfhi(self.w));
        *(LAS u32x4*)(lds + row * PSTR + ch * 16) = o; }
    __syncthreads();
    const int fr = lane & 15, fq = lane >> 4;
    f32x4 acc[12];
#pragma unroll
    for (int nt = 0; nt < 12; ++nt) acc[nt] = (f32x4){0.f, 0.f, 0.f, 0.f};
    const bf16* wg = wpT + (size_t)g * 192 * 192 + (size_t)fr * 192 + 8 * fq;
#pragma unroll
    for (int ks = 0; ks < 6; ++ks) { const bf16x8 af = *(const LAS bf16x8*)(lds + (16 * wid + fr) * PSTR + 64 * ks + 16 * fq);
#pragma unroll
        for (int nt = 0; nt < 12; ++nt) { const bf16x8 bfrag = *(const bf16x8*)(wg + (size_t)nt * 16 * 192 + 32 * ks);
            acc[nt] = __builtin_amdgcn_mfma_f32_16x16x32_bf16(bfrag, af, acc[nt], 0, 0, 0); } }
    bf16* orow = ycat + (size_t)(tok0 + 16 * wid + fr) * DM + g * 192 + 4 * fq;
#pragma unroll
    for (int nt = 0; nt < 12; ++nt) { const f32x4 sc = *(const f32x4*)(scale + g * 192 + 16 * nt + 4 * fq); const f32x4 v = acc[nt] * sc;
        u32x2 o; o.x = pk2(v[0], v[1]); o.y = pk2(v[2], v[3]); *(u32x2*)(orow + 16 * nt) = o; }
    __syncthreads();
}

template <int MODE> __device__ __forceinline__ void attn_unit(LAS unsigned char* lds, int u, const bf16* zq, const bf16* kvbase, bf16* ycat, float* lse, int tid, int wid, int lane) {
    constexpr int KSTR = 144, VOFF = 256 * KSTR;
    int b, qcol, d = 1, r = 0, n = 0, gh = 0, qt0 = 0; int kpitch, kcol, vcol;
    if (MODE == 0) { b = u / 192; const int rem = u % 192; gh = rem >> 4; const int rn = rem & 15, g = gh >> 2; d = (g == 0) ? 1 : (g == 1) ? 4 : 16; const int nb = 16 / d; r = rn / nb; n = rn % nb;
        qcol = gh * 64; kpitch = 1536; kcol = gh * 64; vcol = MAINW + gh * 64; }
    else { b = u >> 6; const int rem = u & 63, h = rem >> 4; qt0 = (rem & 15) * 128; qcol = MAINW + h * 64; kpitch = 512; kcol = h * 64; vcol = 256 + h * 64; }
#pragma unroll
    for (int i = 0; i < 4; ++i) { const int idx = tid + NTHREADS * i, row = idx >> 3, ch = idx & 7; size_t tok;
        if (MODE == 0) { int lk = 128 * (n - 1) + row; lk = lk < 0 ? 0 : lk; tok = (size_t)b * SEQ + (size_t)lk * d + r; } else tok = (size_t)b * NMEM + row;
        const bf16* kp = kvbase + tok * kpitch + ch * 8;
        const u32x4 kv = *(const u32x4*)(kp + kcol), vv = *(const u32x4*)(kp + vcol);
        *(LAS u32x4*)(lds + row * KSTR + ch * 16) = kv; *(LAS u32x4*)(lds + VOFF + row * KSTR + ch * 16) = vv; }
    const int fr = lane & 15, fq = lane >> 4;
    const int iq = 16 * wid + fr;
    const size_t qtok = (MODE == 0) ? ((size_t)b * SEQ + (size_t)(128 * n + iq) * d + r) : ((size_t)b * SEQ + qt0 + iq);
    bf16x8 qf[2];
    qf[0] = *(const bf16x8*)(zq + qtok * DM + qcol + 8 * fq); qf[1] = *(const bf16x8*)(zq + qtok * DM + qcol + 32 + 8 * fq);
    __syncthreads();
    constexpr int NT = (MODE == 0) ? 10 : 16;
    const int kt0 = (MODE == 0) ? (wid & ~1) : 0;
    f32x4 s[NT];
#pragma unroll
    for (int kt = 0; kt < NT; ++kt) { const int row = 16 * (kt0 + kt) + fr;
        const bf16x8 a0 = *(const LAS bf16x8*)(lds + row * KSTR + 16 * fq), a1 = *(const LAS bf16x8*)(lds + row * KSTR + 64 + 16 * fq);
        s[kt] = __builtin_amdgcn_mfma_f32_16x16x32_bf16(a0, qf[0], (f32x4){0.f, 0.f, 0.f, 0.f}, 0, 0, 0);
        s[kt] = __builtin_amdgcn_mfma_f32_16x16x32_bf16(a1, qf[1], s[kt], 0, 0, 0); }
    float mx = -3.0e38f;
#pragma unroll
    for (int kt = 0; kt < NT; ++kt)
#pragma unroll
        for (int jj = 0; jj < 4; ++jj) {
            if (MODE == 0) { const int j = 16 * (kt0 + kt) + 4 * fq + jj, rel = iq + 128 - j; const bool ok = (rel >= 0) && (rel <= 128) && (n > 0 || j >= 128); s[kt][jj] = ok ? s[kt][jj] : -1.0e30f; }
            mx = fmaxf(mx, s[kt][jj]); }
    mx = fmaxf(mx, __shfl_xor(mx, 16)); mx = fmaxf(mx, __shfl_xor(mx, 32));
    float sum = 0.f;
#pragma unroll
    for (int kt = 0; kt < NT; ++kt)
#pragma unroll
        for (int jj = 0; jj < 4; ++jj) { const float p = __builtin_amdgcn_exp2f(s[kt][jj] - mx); s[kt][jj] = p; sum += p; }
    sum += __shfl_xor(sum, 16); sum += __shfl_xor(sum, 32);
    f32x4 o[4];
#pragma unroll
    for (int dt = 0; dt < 4; ++dt) o[dt] = (f32x4){0.f, 0.f, 0.f, 0.f};
    const int q4 = (lane & 15) >> 2, p4 = lane & 3;
#pragma unroll
    for (int k = 0; k < NT / 2; ++k) {
        u32x4 pw; pw.x = pk2(s[2 * k][0], s[2 * k][1]); pw.y = pk2(s[2 * k][2], s[2 * k][3]); pw.z = pk2(s[2 * k + 1][0], s[2 * k + 1][1]); pw.w = pk2(s[2 * k + 1][2], s[2 * k + 1][3]);
        const bf16x8 pf = __builtin_bit_cast(bf16x8, pw);
        const int rowb = 16 * kt0 + 32 * k + 4 * fq + q4;
#pragma unroll
        for (int dt = 0; dt < 4; ++dt) { LAS unsigned char* vp = lds + VOFF + rowb * KSTR + (16 * dt + 4 * p4) * 2;
            const v4i16_t lo = __builtin_amdgcn_ds_read_tr16_b64_v4i16((LAS v4i16_t*)vp), hi = __builtin_amdgcn_ds_read_tr16_b64_v4i16((LAS v4i16_t*)(vp + 16 * KSTR));
            const bf16x8 vf = (bf16x8){lo[0], lo[1], lo[2], lo[3], hi[0], hi[1], hi[2], hi[3]};
            o[dt] = __builtin_amdgcn_mfma_f32_16x16x32_bf16(vf, pf, o[dt], 0, 0, 0); } }
    const float inv = 1.0f / sum;
    bf16* op = ycat + qtok * DM + qcol + 4 * fq;
#pragma unroll
    for (int dt = 0; dt < 4; ++dt) { u32x2 w; w.x = pk2(o[dt][0] * inv, o[dt][1] * inv); w.y = pk2(o[dt][2] * inv, o[dt][3] * inv); *(u32x2*)(op + 16 * dt) = w; }
    if (MODE == 0) { if (fq == 0) lse[qtok * 12 + gh] = (mx + __log2f(sum)) * 0.6931471805599453f; }
    __syncthreads();
}

#define RLX_AGENT __ATOMIC_RELAXED, __HIP_MEMORY_SCOPE_AGENT
#define XB_TMO      128
#define XB_XCNT(j)  (256  + 64 * (j))
#define XB_XSUB(j)  (1280 + 64 * (j))
#define XB_XGEN(j)  (2304 + 64 * (j))
#define XB_TOP      3328
#define XB_TOPGEN   3392
#define XCD_BAR_WORDS 3456
#define XB_SPIN_CAP (1u << 18)

__device__ __forceinline__ unsigned xb_ld(unsigned* p)              { return __hip_atomic_load(p, __ATOMIC_RELAXED, __HIP_MEMORY_SCOPE_AGENT); }
__device__ __forceinline__ unsigned xb_add(unsigned* p, unsigned v) { return __hip_atomic_fetch_add(p, v, __ATOMIC_RELAXED, __HIP_MEMORY_SCOPE_AGENT); }
__device__ __forceinline__ unsigned xb_xcc_id() { return (unsigned)__builtin_amdgcn_s_getreg((3 << 11) | 20) & 0xFu; }
#define XB_SPIN(cond, bar) do { unsigned _sp = 0; while (cond) { __builtin_amdgcn_s_sleep(1); \
    if ((++_sp & 255u) == 0u) { if (xb_ld(&(bar)[XB_TMO])) break; if (_sp > XB_SPIN_CAP) { atomicAdd(&(bar)[XB_TMO], 1u); break; } } } } while (0)

struct XcdBarrier {
    unsigned* bar; unsigned x;
    volatile LAS unsigned* st;
};

__device__ __forceinline__ XcdBarrier xcd_barrier_post(unsigned* bar, volatile LAS unsigned* st) {
    XcdBarrier b; b.bar = bar; b.x = xb_xcc_id(); b.st = st;
    if (threadIdx.x == 0) (void)xb_add(&bar[XB_XCNT(b.x)], 1u);
    return b;
}
__device__ __forceinline__ void xcd_barrier_complete(unsigned* bar, unsigned x, unsigned& nloc, unsigned& nx) {
    const unsigned G = gridDim.x * gridDim.y * gridDim.z;
    unsigned sum, cnt, mine, sp = 0u;
    for (;;) {
        sum = 0u; cnt = 0u; mine = 0u;
#pragma unroll
        for (unsigned j = 0; j < 16; ++j) { const unsigned c = xb_ld(&bar[XB_XCNT(j)]); sum += c; cnt += (c > 0u) ? 1u : 0u; mine = (j == x) ? c : mine; }
        if (sum == G) break;
        __builtin_amdgcn_s_sleep(1);
        if ((++sp & 255u) == 0u) { if (xb_ld(&bar[XB_TMO])) break; if (sp > XB_SPIN_CAP) { atomicAdd(&bar[XB_TMO], 1u); break; } }
    }
    nloc = mine > 0u ? mine : 1u; nx = cnt > 0u ? cnt : 1u;
}

__device__ __forceinline__ void xcd_barrier(const XcdBarrier& b) {
    asm volatile("s_waitcnt vmcnt(0)" ::: "memory");
    __syncthreads();
    if (threadIdx.x == 0) {
        unsigned* bar = b.bar;
        __builtin_amdgcn_s_waitcnt(0);
        unsigned nloc = b.st[0], nx = b.st[1];
        if (nloc == 0u) { xcd_barrier_complete(bar, b.x, nloc, nx); b.st[0] = nloc; b.st[1] = nx; }
        const unsigned old = xb_add(&bar[XB_XSUB(b.x)], 1u);
        const unsigned gen = old / nloc;
        if (old + 1u == (gen + 1u) * nloc) {
            __builtin_amdgcn_fence(__ATOMIC_RELEASE, "agent");
            asm volatile("s_waitcnt vmcnt(0)" ::: "memory");
            const unsigned og = xb_add(&bar[XB_TOP], 1u);
            const unsigned tg = og / nx;
            if (og + 1u == (tg + 1u) * nx) xb_add(&bar[XB_TOPGEN], 1u);
            else XB_SPIN(xb_ld(&bar[XB_TOPGEN]) == tg, bar);
            __builtin_amdgcn_fence(__ATOMIC_ACQUIRE, "agent");
            xb_add(&bar[XB_XGEN(b.x)], 1u);
            asm volatile("s_waitcnt vmcnt(0)" ::: "memory");
        } else {
            XB_SPIN(xb_ld(&bar[XB_XGEN(b.x)]) == gen, bar);
            __builtin_amdgcn_fence(__ATOMIC_ACQUIRE, "agent");
            asm volatile("s_waitcnt vmcnt(0)" ::: "memory");
        }
    }
    __syncthreads();
}

constexpr int STASH_OFF = 131072;
__device__ __forceinline__ unsigned char* ldp(LAS unsigned char* lds, int i) {
    const volatile LAS unsigned* p = (const volatile LAS unsigned*)(lds + STASH_OFF + 8 * i);
    const unsigned lo = __builtin_amdgcn_readfirstlane(p[0]), hi = __builtin_amdgcn_readfirstlane(p[1]);
    return (unsigned char*)(((unsigned long long)hi << 32) | lo);
}
enum { SL_WS = 0, SL_X = 1, SL_OUT = 2, SL_NG = 3, SL_PSC = 4 };
__global__ void __launch_bounds__(NTHREADS, 2) yoco_fwd(Args A) {
    extern __shared__ __attribute__((aligned(16))) unsigned char lds_raw[];
    cg::grid_group grid = cg::this_grid();
    LAS unsigned char* lds = (LAS unsigned char*)lds_raw;
    {
        const int tid = threadIdx.x, lane = tid & 63, wid = __builtin_amdgcn_readfirstlane(tid >> 6);
        if (blockIdx.x == 0) { unsigned* bw = (unsigned*)A.ws; for (int i = tid; i < XCD_BAR_WORDS; i += NTHREADS) bw[i] = 0u; }
        if (tid == 0) { ((volatile LAS unsigned*)(lds + STASH_OFF + 256))[0] = 0u; ((volatile LAS unsigned*)(lds + STASH_OFF + 256))[1] = 0u; }
        if (tid == 0) { LAS unsigned long long* sl = (LAS unsigned long long*)(lds + STASH_OFF);
            sl[SL_WS] = (unsigned long long)A.ws; sl[SL_X] = (unsigned long long)A.x; sl[SL_OUT] = (unsigned long long)A.out; sl[SL_NG] = (unsigned long long)A.norm_gains; sl[SL_PSC] = (unsigned long long)A.pool_scale; }
        p0_prologue(A, lds, tid, wid, lane);
    }
    grid.sync();
    (void)xcd_barrier_post((unsigned*)ldp(lds, SL_WS), (volatile LAS unsigned*)(lds + STASH_OFF + 256));
#define XBAR() do { XcdBarrier b_; b_.bar = (unsigned*)ldp(lds, SL_WS); b_.x = xb_xcc_id(); b_.st = (volatile LAS unsigned*)(lds + STASH_OFF + 256); xcd_barrier(b_); } while (0)

    for (int step = -1; step < 16; ++step) {
        const int l = step >> 2, k = (step < 0) ? -1 : (step & 3);
        {
            unsigned char* ws = ldp(lds, SL_WS);
            const unsigned char* wl = ws + WS_W + (size_t)(step < 0 ? 0 : l) * WL_STRIDE;
            bf16* XY = (bf16*)(ws + WS_XY);
            pg8::Gemm g; pg8::EpiAll E; E.rope = (const float*)(ws + WS_ROPE); E.o1 = (bf16*)(ws + WS_KVS); E.rs = (const float*)(ws + WS_RX);
            const int G = gridDim.x;
            if (k == 3) {
                g = pg8::Gemm{(const bf16*)(ws + WS_A), (const bf16*)(wl + WL_DOWN), MT, DM, DFF}; E.kind = 3; E.o0 = XY;
                pg8::StaticOrder S; S.init(g.M, g.N, G, (int)blockIdx.x);
                pg8::gemm_phase<DFF, pg8::EpiAll, pg8::StaticOrder, true, true>(lds, g, S, E);
            } else {
                if (step < 0) { g = pg8::Gemm{(const bf16*)(ws + WS_MEMB), (const bf16*)(ws + WS_WMKV), MMEM, 2048, DM}; E.kind = 2; E.o0 = (bf16*)(ws + WS_KVM); E.rs = (const float*)(ws + WS_RMEM); }
                else if (k == 0) { g = pg8::Gemm{XY, (const bf16*)(wl + WL_IN), MT, (l == 2) ? 2560 : 1024, DM}; E.kind = (l >= 2) ? 1 : 0; E.o0 = (bf16*)(ws + WS_Z); }
                else if (k == 1) { g = pg8::Gemm{(const bf16*)(ws + WS_YCAT), (const bf16*)(wl + WL_OUT), MT, DM, DM}; E.kind = 3; E.o0 = XY; }
                else { g = pg8::Gemm{XY, (const bf16*)(wl + WL_GU), MT, 2 * DFF, DM}; E.kind = 4; E.o0 = (bf16*)(ws + WS_A); }
                pg8::StaticOrder S; S.init(g.M, g.N, G, (int)blockIdx.x);
                pg8::gemm_phase<DM, pg8::EpiAll, pg8::StaticOrder, true, true>(lds, g, S, E);
            }
        }
        if (step < 0) continue;
        XBAR();
        int tid_ = threadIdx.x; asm volatile("" : "+v"(tid_));
        const int tid = tid_, lane = tid & 63, wid = __builtin_amdgcn_readfirstlane(tid >> 6);
        const int G = gridDim.x;
        unsigned char* ws = ldp(lds, SL_WS);
        bf16* XY = (bf16*)(ws + WS_XY); bf16* Z = (bf16*)(ws + WS_Z); bf16* YCAT = (bf16*)(ws + WS_YCAT); float* LSE = (float*)(ws + WS_LSE);
        if (k == 0) {
            const bf16* kvm_l = (const bf16*)(ws + WS_KVM) + (size_t)l * MMEM * 512;
            if (l < 2) {
                const bf16* wpT = (const bf16*)(ws + WS_WPOOL) + (size_t)l * 4 * 192 * 192; const float* psc = (const float*)ldp(lds, SL_PSC) + l * MAINW;
                for (int u = blockIdx.x; u < 1024 + 1024; u += G) {
                    if (u < 1024) pool_unit(lds, u, Z, wpT, psc, YCAT, tid, wid, lane);
                    else attn_unit<1>(lds, u - 1024, Z, kvm_l, YCAT, LSE, tid, wid, lane);
                }
                XBAR();
            } else {
                const bf16* KVS = (const bf16*)(ws + WS_KVS);
                for (int u = blockIdx.x; u < 3072 + 1024; u += G) {
                    if (u < 3072) attn_unit<0>(lds, u, Z, KVS, YCAT, LSE, tid, wid, lane);
                    else attn_unit<1>(lds, u - 3072, Z, kvm_l, YCAT, LSE, tid, wid, lane);
                }
                XBAR();
                const int gt = blockIdx.x * NTHREADS + tid, NGT = G * NTHREADS;
                for (int it = gt; it < MT * 96; it += NGT) { const int tok = it / 96, ch = it % 96, head = ch >> 3, gg = head >> 2, h = head & 3;
                    const float l0 = LSE[(size_t)tok * 12 + h], l1 = LSE[(size_t)tok * 12 + 4 + h], l2 = LSE[(size_t)tok * 12 + 8 + h];
                    const float m = fmaxf(l0, fmaxf(l1, l2)); const float e0 = __expf(l0 - m), e1 = __expf(l1 - m), e2 = __expf(l2 - m);
                    const float al = ((gg == 0) ? e0 : (gg == 1) ? e1 : e2) / (e0 + e1 + e2);
                    u32x4* p = (u32x4*)(YCAT + (size_t)tok * DM + ch * 8); const u32x4 v = *p; u32x4 o;
                    o.x = pk2(bflo(v.x) * al, bfhi(v.x) * al); o.y = pk2(bflo(v.y) * al, bfhi(v.y) * al); o.z = pk2(bflo(v.z) * al, bfhi(v.z) * al); o.w = pk2(bflo(v.w) * al, bfhi(v.w) * al); *p = o; }
                XBAR();
            }
        } else if (k == 1 || k == 3) {
            const int gw = blockIdx.x * 8 + wid, NGW = G * 8;
            float* out = (float*)ldp(lds, SL_OUT);
            const float* xs = (step == 1) ? (const float*)ldp(lds, SL_X) : out; const float* gain = (const float*)ldp(lds, SL_NG) + (l * 4 + k) * DM;
            float* RX = (float*)(ws + WS_RX);
            for (int m = gw; m < MT; m += NGW) {
                const f32x4* xr = (const f32x4*)(xs + (size_t)m * DM) + lane; u32x2* yr = (u32x2*)(XY + (size_t)m * DM) + lane; f32x4* orow = (f32x4*)(out + (size_t)m * DM) + lane;
                u32x2 yy[4]; float sy = 0.f;
#pragma unroll
                for (int j = 0; j < 4; ++j) { yy[j] = yr[64 * j]; const float a = bflo(yy[j].x), b = bfhi(yy[j].x), c = bflo(yy[j].y), d = bfhi(yy[j].y); sy += (a * a + b * b) + (c * c + d * d); }
                sy = wave_sum(sy);
                const float ry = 1.0f / sqrtf(sy * (1.f / DM) + EPS); float s = 0.f; f32x4 v[4];
#pragma unroll
                for (int j = 0; j < 4; ++j) { const f32x4 xv = xr[64 * j]; const u32x2 yv = yy[j]; const f32x4 gv = *((const f32x4*)gain + lane + 64 * j);
                    v[j][0] = xv[0] + bflo(yv.x) * ry * gv[0]; v[j][1] = xv[1] + bfhi(yv.x) * ry * gv[1]; v[j][2] = xv[2] + bflo(yv.y) * ry * gv[2]; v[j][3] = xv[3] + bfhi(yv.y) * ry * gv[3];
                    s += (v[j][0] * v[j][0] + v[j][1] * v[j][1]) + (v[j][2] * v[j][2] + v[j][3] * v[j][3]); }
                s = wave_sum(s);
#pragma unroll
                for (int j = 0; j < 4; ++j) { orow[64 * j] = v[j]; u32x2 w; w.x = pk2(v[j][0], v[j][1]); w.y = pk2(v[j][2], v[j][3]); yr[64 * j] = w; }
                if (lane == 0) RX[m] = 1.0f / sqrtf(s * (1.f / DM) + EPS);
            }
            XBAR();
        }
    }
}

extern "C" void kernel_launch(void* const* d_in, const int* in_sizes, int n_in, void* d_out, int out_size, void* d_ws, size_t ws_size, hipStream_t stream) {
    static int grid = 0;
    if (grid == 0) {
        if (n_in != 14 || out_size != MT * DM || ws_size < WS_END) { fprintf(stderr, "kernel_launch: unexpected shapes (n_in %d, out %d, ws %zu)\n", n_in, out_size, ws_size); grid = -1; return; }
        int dev = 0, cus = 0, per_cu = 0;
        (void)hipGetDevice(&dev); (void)hipDeviceGetAttribute(&cus, hipDeviceAttributeMultiprocessorCount, dev);
        (void)hipFuncSetAttribute((const void*)yoco_fwd, hipFuncAttributeMaxDynamicSharedMemorySize, LDS_BYTES);
        (void)hipOccupancyMaxActiveBlocksPerMultiprocessor(&per_cu, (const void*)yoco_fwd, NTHREADS, LDS_BYTES);
        if (per_cu < 1) per_cu = 1;
        grid = cus * per_cu;
    }
    if (grid < 0) return;
    Args a{};
    a.x = (const float*)d_in[0]; a.mem = (const float*)d_in[1]; a.pos = (const int*)d_in[2]; a.norm_gains = (const float*)d_in[3]; a.mem_norm = (const float*)d_in[4];
    a.w_in = (const float*)d_in[5]; a.w_mem_kv = (const float*)d_in[6]; a.w_out = (const float*)d_in[7]; a.w_pool = (const float*)d_in[8]; a.pool_scale = (const float*)d_in[9];
    a.kv_norm = (const float*)d_in[10]; a.w_kv = (const float*)d_in[11]; a.w_gate_up = (const float*)d_in[12]; a.w_down = (const float*)d_in[13];
    a.out = (float*)d_out; a.ws = (unsigned char*)d_ws;
    void* args[] = {&a};
    hipError_t e = hipLaunchCooperativeKernel((const void*)yoco_fwd, dim3(grid), dim3(NTHREADS), args, LDS_BYTES, stream);
    if (e != hipSuccess) fprintf(stderr, "kernel_launch: cooperative launch failed: %s (grid %d)\n", hipGetErrorString(e), grid);
}
```
